# Optimizing an MI355X kernel written in HIP

```python
import math
import jax, jax.numpy as jnp
from jax import lax
import numpy as np

D_MODEL = 1024
BATCH = 32
SEQ = 2048
DEPTH = 1

RWKV_WIDTH = 512
RWKV_HEAD = 64
RWKV_HEADS = RWKV_WIDTH // RWKV_HEAD
LORA_W = 64
LORA_A = 64
LORA_G = 128
S5_WIDTH = 512
S5_GROUP = 16
S5_GROUPS = S5_WIDTH // S5_GROUP
S5_STATE = 64
N_BRANCH = 2
D_FF = 2816
CONV_W = 3
RMS_EPS = 1e-6
GN_EPS = 64e-5
L2_EPS = 1e-12
DT_MIN = 1e-3
DT_MAX = 1e-1
SHIFT_COLS = 3 * RWKV_WIDTH + LORA_W + LORA_A + LORA_G
IN_COLS = SHIFT_COLS + S5_WIDTH + N_BRANCH * D_MODEL

kernel_name = "hybrid_rwkv7_s5_convffn_adaln"


def _rms_norm(x, g):
    xf = x.astype(jnp.float32)
    y = xf * lax.rsqrt(jnp.mean(xf * xf, axis=-1, keepdims=True) + RMS_EPS)
    return (y * g.astype(jnp.float32)).astype(x.dtype)


def _token_shift(p, mu):
    prev = jnp.pad(p, ((0, 0), (1, 0), (0, 0)))[:, :-1]
    return p + (prev - p) * mu


def _causal_dwconv(u, w, b):
    up = jnp.pad(u, ((0, 0), (CONV_W - 1, 0), (0, 0)))
    s = u.shape[1]
    y = b
    for j in range(CONV_W):
        y = y + w[j] * up[:, j:j + s]
    return y


def _wkv7(r, decay, k, v, a, b):
    bsz, _, h, n = r.shape

    def step(state, inp):
        r_t, w_t, k_t, v_t, a_t, b_t = inp
        sa = jnp.einsum('bhvk,bhk->bhv', state, a_t)
        state = (state * w_t[:, :, None, :] + sa[..., None] * b_t[:, :, None, :]
                 + v_t[..., None] * k_t[:, :, None, :])
        y_t = jnp.einsum('bhvk,bhk->bhv', state, r_t)
        return state, y_t

    xs = (jnp.moveaxis(r, 1, 0), jnp.moveaxis(decay, 1, 0), jnp.moveaxis(k, 1, 0),
          jnp.moveaxis(v, 1, 0), jnp.moveaxis(a, 1, 0), jnp.moveaxis(b, 1, 0))
    state0 = jnp.zeros((bsz, h, n, n), r.dtype)
    _, ys = lax.scan(step, state0, xs)
    return jnp.moveaxis(ys, 0, 1)


def _rwkv7_branch(p, w0, w_up, a0, a_up, g_up, k_k, k_a, r_k, ln_g, ln_b):
    bsz, s, _ = p.shape
    W, H, N = RWKV_WIDTH, RWKV_HEADS, RWKV_HEAD
    r, k, v, wd, ad, gd = jnp.split(
        p, [W, 2 * W, 3 * W, 3 * W + LORA_W, 3 * W + LORA_W + LORA_A], axis=-1)
    w_raw = w0 + jnp.tanh(wd) @ w_up
    log_w = -jax.nn.softplus(-w_raw) - 0.5
    decay = jnp.exp(-jnp.exp(log_w))
    a = jax.nn.sigmoid(a0 + ad @ a_up)
    g = jax.nn.sigmoid(gd) @ g_up
    heads = lambda t: t.reshape(bsz, s, H, N)
    kk = heads(k * k_k).astype(jnp.float32)
    kk = (kk * lax.rsqrt(jnp.sum(kk * kk, axis=-1, keepdims=True) + L2_EPS)).astype(k.dtype)
    k = k * (1.0 + (a - 1.0) * k_a)
    r_h, k_h, v_h, a_h = heads(r), heads(k), heads(v), heads(a)
    y = _wkv7(r_h, heads(decay), k_h, v_h, -kk, kk * a_h)
    yf = y.astype(jnp.float32)
    mean = jnp.mean(yf, axis=-1, keepdims=True)
    var = jnp.mean(jnp.square(yf - mean), axis=-1, keepdims=True)
    y = ((yf - mean) * lax.rsqrt(var + GN_EPS)).astype(y.dtype)
    y = y * ln_g.reshape(H, N) + ln_b.reshape(H, N)
    bonus = jnp.sum(r_h * k_h * r_k, axis=-1, keepdims=True) * v_h
    return (y + bonus).reshape(bsz, s, W) * g


def _complex_linear_combine(e_i, e_j):
    a_re_i, a_im_i, b_re_i, b_im_i = e_i
    a_re_j, a_im_j, b_re_j, b_im_j = e_j
    a_re = a_re_j * a_re_i - a_im_j * a_im_i
    a_im = a_re_j * a_im_i + a_im_j * a_re_i
    b_re = a_re_j * b_re_i - a_im_j * b_im_i + b_re_j
    b_im = a_re_j * b_im_i + a_im_j * b_re_i + b_im_j
    return (a_re, a_im, b_re, b_im)


def _s5_branch(u, a_re, a_im, log_dt, b_re, b_im, c_re, c_im, d, w_glu):
    bsz, s, _ = u.shape
    G, P, C = S5_GROUPS, S5_STATE, S5_GROUP
    dt = jnp.exp(log_dt)[:, None]
    z_re, z_im = a_re * dt, a_im * dt
    mag = jnp.exp(z_re)
    ab_re, ab_im = mag * jnp.cos(z_im), mag * jnp.sin(z_im)
    den = a_re * a_re + a_im * a_im
    q_re = ((ab_re - 1.0) * a_re + ab_im * a_im) / den
    q_im = (ab_im * a_re - (ab_re - 1.0) * a_im) / den
    bb_re = q_re[..., None] * b_re - q_im[..., None] * b_im
    bb_im = q_re[..., None] * b_im + q_im[..., None] * b_re
    ug = u.reshape(bsz, s, G, C)
    bu_re = jnp.einsum('bsgc,gpc->bsgp', ug, bb_re)
    bu_im = jnp.einsum('bsgc,gpc->bsgp', ug, bb_im)
    a_seq_re = jnp.broadcast_to(ab_re[None, None], (1, s, G, P))
    a_seq_im = jnp.broadcast_to(ab_im[None, None], (1, s, G, P))
    _, _, x_re, x_im = lax.associative_scan(
        _complex_linear_combine, (a_seq_re, a_seq_im, bu_re, bu_im), axis=1)
    y = jnp.einsum('bsgp,gcp->bsgc', x_re, c_re) - jnp.einsum('bsgp,gcp->bsgc', x_im, c_im)
    y = y.reshape(bsz, s, S5_WIDTH) + d * u
    y = jax.nn.gelu(y)
    glu_a, glu_b = jnp.split(y @ w_glu, 2, axis=-1)
    return glu_a * jax.nn.sigmoid(glu_b)


def setup_inputs(seed: int = 0) -> dict:
    key = jax.random.key(seed)
    ks = iter(jax.random.split(key, 40))
    L = DEPTH

    def nrm(shape, scale):
        return scale * jax.random.normal(next(ks), shape, jnp.float32)

    def uni(shape, lo, hi):
        return jax.random.uniform(next(ks), shape, jnp.float32, lo, hi)

    n_idx = jnp.arange(S5_STATE, dtype=jnp.float32)
    return {
        "x": nrm((BATCH, SEQ, D_MODEL), 1.0),
        "c": nrm((BATCH, D_MODEL), 1.0),
        "w_ada": nrm((L, D_MODEL, 6 * D_MODEL), 0.02),
        "b_ada": nrm((L, 6 * D_MODEL), 0.02),
        "norm1_g": 1.0 + nrm((L, D_MODEL), 0.02),
        "w_in": nrm((L, D_MODEL, IN_COLS), D_MODEL ** -0.5),
        "mu_shift": uni((L, SHIFT_COLS), 0.0, 1.0),
        "rwkv_w0": uni((L, RWKV_WIDTH), -6.0, -0.5),
        "rwkv_w_up": nrm((L, LORA_W, RWKV_WIDTH), LORA_W ** -0.5),
        "rwkv_a0": nrm((L, RWKV_WIDTH), 0.1),
        "rwkv_a_up": nrm((L, LORA_A, RWKV_WIDTH), LORA_A ** -0.5),
        "rwkv_g_up": nrm((L, LORA_G, RWKV_WIDTH), LORA_G ** -0.5),
        "rwkv_k_k": 0.85 + nrm((L, RWKV_WIDTH), 0.02),
        "rwkv_k_a": 1.0 + nrm((L, RWKV_WIDTH), 0.02),
        "rwkv_r_k": nrm((L, RWKV_HEADS, RWKV_HEAD), 0.1),
        "rwkv_ln_g": 1.0 + nrm((L, RWKV_WIDTH), 0.02),
        "rwkv_ln_b": nrm((L, RWKV_WIDTH), 0.02),
        "w_out_rwkv": nrm((L, RWKV_WIDTH, D_MODEL), RWKV_WIDTH ** -0.5),
        "s5_a_re": -0.5 + nrm((L, S5_GROUPS, S5_STATE), 0.01),
        "s5_a_im": math.pi * n_idx + nrm((L, S5_GROUPS, S5_STATE), 0.01),
        "s5_log_dt": uni((L, S5_GROUPS), math.log(DT_MIN), math.log(DT_MAX)),
        "s5_b_re": nrm((L, S5_GROUPS, S5_STATE, S5_GROUP), (2 * S5_GROUP) ** -0.5),
        "s5_b_im": nrm((L, S5_GROUPS, S5_STATE, S5_GROUP), (2 * S5_GROUP) ** -0.5),
        "s5_c_re": nrm((L, S5_GROUPS, S5_GROUP, S5_STATE), (2 * S5_STATE) ** -0.5),
        "s5_c_im": nrm((L, S5_GROUPS, S5_GROUP, S5_STATE), (2 * S5_STATE) ** -0.5),
        "s5_d": nrm((L, S5_WIDTH), 1.0),
        "w_glu": nrm((L, S5_WIDTH, 2 * D_MODEL), S5_WIDTH ** -0.5),
        "w_out": nrm((L, D_MODEL, D_MODEL), D_MODEL ** -0.5),
        "norm2_g": 1.0 + nrm((L, D_MODEL), 0.02),
        "w_ffn_up": nrm((L, D_MODEL, 2 * D_FF), D_MODEL ** -0.5),
        "ffn_conv_w": nrm((L, CONV_W, 2 * D_FF), CONV_W ** -0.5),
        "ffn_conv_b": nrm((L, 2 * D_FF), 0.02),
        "w_ffn_down": nrm((L, D_FF, D_MODEL), D_FF ** -0.5),
        "norm_f_g": 1.0 + nrm((D_MODEL,), 0.02),
    }


def reference(x, c, w_ada, b_ada, norm1_g, w_in, mu_shift, rwkv_w0, rwkv_w_up, rwkv_a0,
              rwkv_a_up, rwkv_g_up, rwkv_k_k, rwkv_k_a, rwkv_r_k, rwkv_ln_g, rwkv_ln_b,
              w_out_rwkv, s5_a_re, s5_a_im, s5_log_dt, s5_b_re, s5_b_im, s5_c_re, s5_c_im,
              s5_d, w_glu, w_out, norm2_g, w_ffn_up, ffn_conv_w, ffn_conv_b, w_ffn_down,
              norm_f_g):
    for l in range(DEPTH):
        mod = (jax.nn.silu(c) @ w_ada[l] + b_ada[l])[:, None, :]
        sh1, sc1, gt1, sh2, sc2, gt2 = jnp.split(mod, 6, axis=-1)

        h = _rms_norm(x, norm1_g[l]) * (1.0 + sc1) + sh1
        proj = h @ w_in[l]
        p_rwkv, u_s5, gates = jnp.split(proj, [SHIFT_COLS, SHIFT_COLS + S5_WIDTH], axis=-1)
        p_rwkv = _token_shift(p_rwkv, mu_shift[l])
        y_a = _rwkv7_branch(p_rwkv, rwkv_w0[l], rwkv_w_up[l], rwkv_a0[l], rwkv_a_up[l],
                            rwkv_g_up[l], rwkv_k_k[l], rwkv_k_a[l], rwkv_r_k[l],
                            rwkv_ln_g[l], rwkv_ln_b[l]) @ w_out_rwkv[l]
        y_b = _s5_branch(u_s5, s5_a_re[l], s5_a_im[l], s5_log_dt[l], s5_b_re[l], s5_b_im[l],
                         s5_c_re[l], s5_c_im[l], s5_d[l], w_glu[l])
        g_a, g_b = jnp.split(jax.nn.sigmoid(gates), 2, axis=-1)
        mixed = (g_a * y_a + g_b * y_b) @ w_out[l]
        x = x + gt1 * mixed

        h = _rms_norm(x, norm2_g[l]) * (1.0 + sc2) + sh2
        hid = _causal_dwconv(h @ w_ffn_up[l], ffn_conv_w[l], ffn_conv_b[l])
        gate, up = jnp.split(hid, 2, axis=-1)
        x = x + gt2 * ((jax.nn.silu(gate) * up) @ w_ffn_down[l])
    return _rms_norm(x, norm_f_g)
```

```cpp
#include <hip/hip_runtime.h>
#include <hip/hip_cooperative_groups.h>
#include <cstdio>
#include <cstdint>
namespace cg = cooperative_groups;

#define LAS __attribute__((address_space(3)))
typedef unsigned short bf16_t;
typedef short bf16x8 __attribute__((ext_vector_type(8)));
typedef float f32x4 __attribute__((ext_vector_type(4)));
typedef float f32x2 __attribute__((ext_vector_type(2)));
typedef unsigned u32x4 __attribute__((ext_vector_type(4)));
typedef unsigned u32x2 __attribute__((ext_vector_type(2)));

constexpr int T_ = 65536, D_ = 1024, SQ = 2048;
constexpr int INC = 4352, SHC = 1792, FF = 2816, FF2 = 5632, MODC = 6144;
constexpr int LDS_BYTES = 147456;
constexpr int LDS_BARW = LDS_BYTES - 16;
constexpr int NPH = 14;
#ifndef PHM
#define PHM 0xFFFFFu
#endif
#ifndef DUP_PHASE
#define DUP_PHASE -1
#endif

constexpr size_t MiB = 1048576;
constexpr size_t WS_CTL = 0;
constexpr size_t WS_MOD = 16384;
constexpr size_t WS_WIN = 1 * MiB;
constexpr size_t WS_WLORA = WS_WIN + (size_t)INC * 1024 * 2;
constexpr size_t WS_WOR = WS_WLORA + (size_t)1536 * 256 * 2;
constexpr size_t WS_WGLU = WS_WOR + (size_t)1024 * 512 * 2;
constexpr size_t WS_WOUT = WS_WGLU + (size_t)2048 * 512 * 2;
constexpr size_t WS_WUP = WS_WOUT + (size_t)1024 * 1024 * 2;
constexpr size_t WS_WDN = WS_WUP + (size_t)FF2 * 1024 * 2;
constexpr size_t WS_WEND = WS_WDN + (size_t)1024 * FF * 2;
static_assert(WS_WEND <= 32 * MiB, "weights overflow");
constexpr size_t WS_HB = 32 * MiB;
constexpr size_t WS_X1 = 160 * MiB;
constexpr size_t WS_PR = WS_X1;
constexpr size_t WS_LIN = WS_X1 + (size_t)T_ * SHC * 2;
constexpr size_t WS_U5 = 416 * MiB;
constexpr size_t WS_E = 480 * MiB;
constexpr size_t WS_AA = 544 * MiB;
constexpr size_t WS_GG = 608 * MiB;
constexpr size_t WS_YR = 672 * MiB;
constexpr size_t WS_D1 = WS_X1;
constexpr size_t WS_ACT = 416 * MiB;
constexpr size_t WS_HALO = 768 * MiB;
constexpr size_t WS_END = 944 * MiB;

struct Params {
    const float* in[34];
    float* out;
    unsigned char* ws;
    int ph_lo, ph_hi;
};
typedef const __attribute__((address_space(4))) Params* KP;
#define LAUNDER_TID(t) asm volatile("" : "+v"(t))
#define LAUNDER_S(x) asm volatile("" : "+s"(x))

__device__ __forceinline__ unsigned pk2(float lo, float hi) { unsigned r; asm("v_cvt_pk_bf16_f32 %0, %1, %2" : "=v"(r) : "v"(lo), "v"(hi)); return r; }
__device__ __forceinline__ unsigned f2bf(float f) { return pk2(f, 0.f) & 0xFFFFu; }
__device__ __forceinline__ float bf2f(unsigned short b) { return __uint_as_float(((unsigned)b) << 16); }
__device__ __forceinline__ float bflo(unsigned w) { return __uint_as_float(w << 16); }
__device__ __forceinline__ float bfhi(unsigned w) { return __uint_as_float(w & 0xFFFF0000u); }
__device__ __forceinline__ float sigmoidf_(float x) { return __builtin_amdgcn_rcpf(1.0f + __expf(-x)); }
__device__ __forceinline__ float wave_sum(float v) {
    v += __int_as_float(__builtin_amdgcn_update_dpp(0, __float_as_int(v), 0xB1, 0xF, 0xF, false));
    v += __int_as_float(__builtin_amdgcn_update_dpp(0, __float_as_int(v), 0x4E, 0xF, 0xF, false));
    v += __int_as_float(__builtin_amdgcn_update_dpp(0, __float_as_int(v), 0x141, 0xF, 0xF, false));
    v += __int_as_float(__builtin_amdgcn_update_dpp(0, __float_as_int(v), 0x140, 0xF, 0xF, false));
    const int iv = __float_as_int(v);
    const float r0 = __int_as_float(__builtin_amdgcn_readlane(iv, 0)), r1 = __int_as_float(__builtin_amdgcn_readlane(iv, 16));
    const float r2 = __int_as_float(__builtin_amdgcn_readlane(iv, 32)), r3 = __int_as_float(__builtin_amdgcn_readlane(iv, 48));
    return (r0 + r1) + (r2 + r3);
}
#define LDS_FENCE() asm volatile("s_waitcnt lgkmcnt(0)" ::: "memory")


#define XB_TMO      128
#define XB_XCNT(j)  (256  + 64 * (j))
#define XB_XSUB(j)  (1280 + 64 * (j))
#define XB_XGEN(j)  (2304 + 64 * (j))
#define XB_TOP      3328
#define XB_TOPGEN   3392
#define XCD_BAR_WORDS 3456
#define XB_SPIN_CAP (1u << 18)
__device__ __forceinline__ unsigned xb_ld(unsigned* p)              { return __hip_atomic_load(p, __ATOMIC_RELAXED, __HIP_MEMORY_SCOPE_AGENT); }
__device__ __forceinline__ unsigned xb_add(unsigned* p, unsigned v) { return __hip_atomic_fetch_add(p, v, __ATOMIC_RELAXED, __HIP_MEMORY_SCOPE_AGENT); }
__device__ __forceinline__ unsigned xb_xcc_id() { return (unsigned)__builtin_amdgcn_s_getreg((3 << 11) | 20) & 0xFu; }
#define XB_SPIN(cond, bar) do { unsigned _sp = 0; while (cond) { __builtin_amdgcn_s_sleep(1); \
    if ((++_sp & 255u) == 0u) { if (xb_ld(&(bar)[XB_TMO])) break; if (_sp > XB_SPIN_CAP) { atomicAdd(&(bar)[XB_TMO], 1u); break; } } } } while (0)
struct XcdBarrier { unsigned* bar; unsigned x; volatile LAS unsigned* st; };
__device__ __forceinline__ XcdBarrier xcd_barrier_post(unsigned* bar, volatile LAS unsigned* st) {
    XcdBarrier b; b.bar = bar; b.x = xb_xcc_id(); b.st = st;
    if (threadIdx.x == 0) (void)xb_add(&bar[XB_XCNT(b.x)], 1u);
    return b;
}
__device__ __forceinline__ void xcd_barrier_complete(unsigned* bar, unsigned x, unsigned& nloc, unsigned& nx) {
    const unsigned G = gridDim.x * gridDim.y * gridDim.z;
    unsigned sum, cnt, mine, sp = 0u;
    for (;;) {
        sum = 0u; cnt = 0u; mine = 0u;
#pragma unroll
        for (unsigned j = 0; j < 16; ++j) { const unsigned c = xb_ld(&bar[XB_XCNT(j)]); sum += c; cnt += (c > 0u) ? 1u : 0u; mine = (j == x) ? c : mine; }
        if (sum == G) break;
        __builtin_amdgcn_s_sleep(1);
        if ((++sp & 255u) == 0u) { if (xb_ld(&bar[XB_TMO])) break; if (sp > XB_SPIN_CAP) { atomicAdd(&bar[XB_TMO], 1u); break; } }
    }
    nloc = mine > 0u ? mine : 1u; nx = cnt > 0u ? cnt : 1u;
}
__device__ __forceinline__ void xcd_barrier(const XcdBarrier& b) {
    asm volatile("s_waitcnt vmcnt(0)" ::: "memory");
    __syncthreads();
    if (threadIdx.x == 0) {
        unsigned* bar = b.bar;
        __builtin_amdgcn_s_waitcnt(0);
        unsigned nloc = b.st[0], nx = b.st[1];
        if (nloc == 0u) { xcd_barrier_complete(bar, b.x, nloc, nx); b.st[0] = nloc; b.st[1] = nx; }
        const unsigned old = xb_add(&bar[XB_XSUB(b.x)], 1u);
        const unsigned gen = old / nloc;
        if (old + 1u == (gen + 1u) * nloc) {
            __builtin_amdgcn_fence(__ATOMIC_RELEASE, "agent");
            asm volatile("s_waitcnt vmcnt(0)" ::: "memory");
            const unsigned og = xb_add(&bar[XB_TOP], 1u);
            const unsigned tg = og / nx;
            if (og + 1u == (tg + 1u) * nx) xb_add(&bar[XB_TOPGEN], 1u);
            else XB_SPIN(xb_ld(&bar[XB_TOPGEN]) == tg, bar);
            __builtin_amdgcn_fence(__ATOMIC_ACQUIRE, "agent");
            xb_add(&bar[XB_XGEN(b.x)], 1u);
            asm volatile("s_waitcnt vmcnt(0)" ::: "memory");
        } else {
            XB_SPIN(xb_ld(&bar[XB_XGEN(b.x)]) == gen, bar);
            __builtin_amdgcn_fence(__ATOMIC_ACQUIRE, "agent");
            asm volatile("s_waitcnt vmcnt(0)" ::: "memory");
        }
    }
    __syncthreads();
}

namespace pg8 {
constexpr int BM = 256, BK = 64, HALF = 128, HTB = HALF * BK * 2, STAGE_BYTES = 8 * HTB, NXCD = 8, WGM = 8;
__host__ __device__ __forceinline__ int lds_byte(int r, int c) { const int st = (r >> 4) * 2 + (c >> 5), rr = r & 15, cc = c & 31, ob = rr * 64 + cc * 2; return st * 1024 + (ob ^ (((ob >> 9) & 1) << 5)); }
__host__ __device__ __forceinline__ void stage_rc(int b, int& R, int& C) { const int st = b / 1024, sb = b % 1024, swz = sb ^ (((sb >> 9) & 1) << 5); R = (st >> 1) * 16 + swz / 64; C = (st & 1) * 32 + (swz % 64) / 2; }
__host__ __device__ __forceinline__ int perm32(int rho) { const int n = rho >> 4, i = rho & 15; return 8 * (i >> 2) + 4 * n + (i & 3); }

struct Unit { int pm, pn; };
struct Gemm { const bf16_t* A; const bf16_t* Bt; int M, N, K; int permA; };

struct StaticOrder {
    int nM, nN, nwg, G, c, owner;
    __device__ void init(int M, int N, int G_, int c_, int owner_) { nM = M / BM; nN = N / BM; nwg = nM * nN; G = G_; c = c_; owner = owner_; }
    __device__ bool next(int i, Unit& u) const {
        if (owner) { if (i >= nN) return false; u.pm = c; u.pn = i; return true; }
        const long L = (long)i * G + c; if (L >= nwg) return false;
        int wgid = (int)L; { const int q = nwg / NXCD, r = nwg % NXCD, xcd = wgid % NXCD, off = wgid / NXCD; wgid = (xcd < r ? xcd * (q + 1) : r * (q + 1) + (xcd - r) * q) + off; }
        const int nig = WGM * nN, gid = wgid / nig, fm = gid * WGM, gsz = (nM - fm) < WGM ? (nM - fm) : WGM;
        u.pm = fm + ((wgid % nig) % gsz); u.pn = (wgid % nig) / gsz; return true;
    }
};

enum { M_ROUTE = 0, M_GLU, M_MIXADD, M_SCALE, M_CONV };
struct Epi {
    int mode;
    int c1, c2, ld0, ld1, ld2, sig2;
    bf16_t *o0, *o1, *o2;
    const bf16_t* gates;
    const float* gatev;
    const float *cw, *cb;
    __device__ __forceinline__ void operator()(const f32x4 (&acc)[2][2][4][2], const Unit& u, int wr, int wc, int fr, int fq) const {
        const int row0 = u.pm * BM + wr * 64 + fr;
        if (mode == M_ROUTE) {
            const int colt = u.pn * BM; bf16_t* base; int ld, cb; bool sig = false;
            if (colt < c1) { base = o0; ld = ld0; cb = colt; }
            else if (colt < c2) { base = o1; ld = ld1; cb = colt - c1; }
            else { base = o2; ld = ld2; cb = colt - c2; sig = sig2 != 0; }
            const int col0 = cb + wc * 32 + 8 * fq;
#pragma unroll
            for (int ai = 0; ai < 2; ++ai)
#pragma unroll
                for (int m = 0; m < 4; ++m) { bf16_t* rowp = base + (size_t)(row0 + ai * HALF + m * 16) * ld + col0;
#pragma unroll
                    for (int bj = 0; bj < 2; ++bj) { f32x4 a = acc[ai][bj][m][0], b = acc[ai][bj][m][1];
                        if (sig) {
#pragma unroll
                            for (int i = 0; i < 4; ++i) { a[i] = sigmoidf_(a[i]); b[i] = sigmoidf_(b[i]); } }
                        u32x4 o; o.x = pk2(a[0], a[1]); o.y = pk2(a[2], a[3]); o.z = pk2(b[0], b[1]); o.w = pk2(b[2], b[3]);
                        __builtin_nontemporal_store(o, (u32x4*)(rowp + bj * HALF)); } }
        } else if (mode == M_GLU) {
            const int col0 = u.pn * HALF + wc * 32 + 8 * fq;
            u32x4 gwv[2][4];
#pragma unroll
            for (int ai = 0; ai < 2; ++ai)
#pragma unroll
                for (int m = 0; m < 4; ++m) gwv[ai][m] = *(const u32x4*)(gates + (size_t)(row0 + ai * HALF + m * 16) * 2048 + 1024 + col0);
            __builtin_amdgcn_sched_barrier(0);
#pragma unroll
            for (int ai = 0; ai < 2; ++ai)
#pragma unroll
                for (int m = 0; m < 4; ++m) { const size_t row = (size_t)(row0 + ai * HALF + m * 16);
                    const u32x4 gw = gwv[ai][m];
                    const f32x4 ga0 = acc[ai][0][m][0], ga1 = acc[ai][0][m][1], gb0 = acc[ai][1][m][0], gb1 = acc[ai][1][m][1];
                    float r[8];
                    r[0] = ga0[0] * sigmoidf_(gb0[0]) * bflo(gw.x); r[1] = ga0[1] * sigmoidf_(gb0[1]) * bfhi(gw.x);
                    r[2] = ga0[2] * sigmoidf_(gb0[2]) * bflo(gw.y); r[3] = ga0[3] * sigmoidf_(gb0[3]) * bfhi(gw.y);
                    r[4] = ga1[0] * sigmoidf_(gb1[0]) * bflo(gw.z); r[5] = ga1[1] * sigmoidf_(gb1[1]) * bfhi(gw.z);
                    r[6] = ga1[2] * sigmoidf_(gb1[2]) * bflo(gw.w); r[7] = ga1[3] * sigmoidf_(gb1[3]) * bfhi(gw.w);
                    u32x4 o; o.x = pk2(r[0], r[1]); o.y = pk2(r[2], r[3]); o.z = pk2(r[4], r[5]); o.w = pk2(r[6], r[7]);
                    *(u32x4*)(o0 + row * 1024 + col0) = o; }
        } else if (mode == M_MIXADD) {
            const int col0 = u.pn * BM + wc * 32 + 8 * fq;
#pragma unroll
            for (int ai = 0; ai < 2; ++ai) {
                u32x4 gwv[4][2], mov[4][2];
#pragma unroll
                for (int m = 0; m < 4; ++m)
#pragma unroll
                    for (int bj = 0; bj < 2; ++bj) { const size_t row = (size_t)(row0 + ai * HALF + m * 16); const int col = col0 + bj * HALF;
                        gwv[m][bj] = *(const u32x4*)(gates + row * 2048 + col); mov[m][bj] = *(const u32x4*)(o0 + row * 1024 + col); }
                __builtin_amdgcn_sched_barrier(0);
#pragma unroll
                for (int m = 0; m < 4; ++m)
#pragma unroll
                    for (int bj = 0; bj < 2; ++bj) { const size_t row = (size_t)(row0 + ai * HALF + m * 16); const int col = col0 + bj * HALF;
                        const u32x4 gw = gwv[m][bj], mo = mov[m][bj];
                        const f32x4 a = acc[ai][bj][m][0], b = acc[ai][bj][m][1];
                        u32x4 o;
                        o.x = pk2(bflo(mo.x) + bflo(gw.x) * a[0], bfhi(mo.x) + bfhi(gw.x) * a[1]);
                        o.y = pk2(bflo(mo.y) + bflo(gw.y) * a[2], bfhi(mo.y) + bfhi(gw.y) * a[3]);
                        o.z = pk2(bflo(mo.z) + bflo(gw.z) * b[0], bfhi(mo.z) + bfhi(gw.z) * b[1]);
                        o.w = pk2(bflo(mo.w) + bflo(gw.w) * b[2], bfhi(mo.w) + bfhi(gw.w) * b[3]);
                        *(u32x4*)(o0 + row * 1024 + col) = o; }
            }
        } else if (mode == M_CONV) {
            const int jc = wc * 32 + 8 * fq, oc0 = u.pn * HALF + jc;
            const int rbase = u.pm * BM + wr * 64 + 4 * fr;
#pragma unroll
            for (int n = 0; n < 2; ++n) {
                const int oc = oc0 + 4 * n;
                f32x4 sg[2][4];
#pragma unroll
                for (int bj = 0; bj < 2; ++bj) {
                    const int wo = bj * FF + oc;
                    const f32x4 w0 = *(const f32x4*)(cw + wo), w1 = *(const f32x4*)(cw + FF2 + wo), w2 = *(const f32x4*)(cw + 2 * FF2 + wo), bb = *(const f32x4*)(cb + wo);
#pragma unroll
                    for (int ai = 0; ai < 2; ++ai) {
                        const f32x4 c0 = acc[ai][bj][0][n], c1 = acc[ai][bj][1][n], c2 = acc[ai][bj][2][n], c3 = acc[ai][bj][3][n];
                        f32x4 p3, p2;
#pragma unroll
                        for (int i = 0; i < 4; ++i) {
                            p3[i] = __int_as_float(__builtin_amdgcn_update_dpp(0, __float_as_int(c3[i]), 0x111, 0xF, 0xF, true));
                            p2[i] = __int_as_float(__builtin_amdgcn_update_dpp(0, __float_as_int(c2[i]), 0x111, 0xF, 0xF, true));
                        }
                        f32x4 ov[4];
                        ov[0] = bb + w2 * c0 + w1 * p3 + w0 * p2; ov[1] = bb + w2 * c1 + w1 * c0 + w0 * p3; ov[2] = bb + w2 * c2 + w1 * c1 + w0 * c0; ov[3] = bb + w2 * c3 + w1 * c2 + w0 * c1;
                        if (fr == 0 || fr == 15) {
                            const int blk = u.pm * 4 + ai * 2 + wr;
                            const f32x4 h0 = fr == 0 ? c0 : c2, h1 = fr == 0 ? c1 : c3;
                            bf16_t* hp = o1 + ((size_t)blk * 4 + (fr == 0 ? 0 : 2)) * FF2 + u.pn * BM + bj * HALF + jc + 4 * n;
                            u32x2 a; a.x = pk2(h0[0], h0[1]); a.y = pk2(h0[2], h0[3]); *(u32x2*)hp = a;
                            u32x2 b; b.x = pk2(h1[0], h1[1]); b.y = pk2(h1[2], h1[3]); *(u32x2*)(hp + FF2) = b;
                        }
                        if (bj == 0) {
#pragma unroll
                            for (int m = 0; m < 4; ++m)
#pragma unroll
                                for (int i = 0; i < 4; ++i) sg[ai][m][i] = ov[m][i] * sigmoidf_(ov[m][i]);
                        } else {
#pragma unroll
                            for (int m = 0; m < 4; ++m) { const f32x4 r = sg[ai][m] * ov[m];
                                u32x2 o; o.x = pk2(r[0], r[1]); o.y = pk2(r[2], r[3]);
                                *(u32x2*)(o0 + (size_t)(rbase + ai * HALF + m) * FF + oc) = o; }
                        }
                    }
                }
            }
        } else {
            const int col0 = u.pn * BM + wc * 32 + 8 * fq;
            const int bidx = (u.pm * BM) >> 11;
            f32x4 gv[2][2];
#pragma unroll
            for (int bj = 0; bj < 2; ++bj)
#pragma unroll
                for (int n = 0; n < 2; ++n) gv[bj][n] = *(const f32x4*)(gatev + (size_t)bidx * MODC + col0 + bj * HALF + 4 * n);
#pragma unroll
            for (int ai = 0; ai < 2; ++ai)
#pragma unroll
                for (int m = 0; m < 4; ++m) { bf16_t* rowp = o0 + (size_t)(row0 + ai * HALF + m * 16) * 1024 + col0;
#pragma unroll
                    for (int bj = 0; bj < 2; ++bj) { const f32x4 a = acc[ai][bj][m][0] * gv[bj][0], b = acc[ai][bj][m][1] * gv[bj][1];
                        u32x4 o; o.x = pk2(a[0], a[1]); o.y = pk2(a[2], a[3]); o.z = pk2(b[0], b[1]); o.w = pk2(b[2], b[3]);
                        *(u32x4*)(rowp + bj * HALF) = o; } }
        }
    }
};

__device__ __forceinline__ void gemm_phase(LAS unsigned char* lds, const Gemm g, const StaticOrder& S, const Epi& E) {
    int tid = threadIdx.x; LAUNDER_TID(tid);
    const int wid = __builtin_amdgcn_readfirstlane(tid >> 6), lane = tid & 63, wr = wid >> 2, wc = wid & 3, fr = lane & 15, fq = lane >> 4;
    const int K = g.K, nt = K / BK;
    unsigned voffA[2], voffB[2];
#pragma unroll
    for (int i = 0; i < 2; ++i) { int R, C; stage_rc(tid * 16 + i * 8192, R, C); const int Rb = (R & ~31) + perm32(R & 31);
        const int Ra = g.permA ? ((R & ~63) + 4 * (R & 15) + ((R >> 4) & 3)) : R;
        voffA[i] = (unsigned)(Ra * K + C) * 2u; voffB[i] = (unsigned)(Rb * K + C) * 2u; }
    const size_t kstep = (size_t)(BK * 2);
    const size_t hstep = (size_t)HALF * K * 2;
    const size_t tstep = 2 * hstep;
    const unsigned ldsw = (unsigned)wid * 1024u;
    const int aoff = lds_byte(wr * 64 + fr, fq * 8), boff = lds_byte(wc * 32 + fr, fq * 8);
#define PG8_SA(b, h) (((b) * 2 + (h)) * HTB)
#define PG8_SB(b, h) ((4 + (b) * 2 + (h)) * HTB)
#define PG8_STAGE(bufoff, gbase, voff) do { _Pragma("unroll") for (int _i = 0; _i < 2; ++_i) \
        __builtin_amdgcn_global_load_lds((const unsigned*)((const char*)(gbase) + (voff)[_i]), (LAS unsigned*)(lds + (bufoff) + ldsw + _i * 8192), 16, 0, 0); } while (0)
#define PG8_LDA(dst, b, h) do { _Pragma("unroll") for (int m = 0; m < 4; ++m) _Pragma("unroll") for (int k = 0; k < 2; ++k) dst[m][k] = *(const LAS bf16x8*)(lds + PG8_SA(b, h) + aoff + m * 2048 + k * 1024); } while (0)
#define PG8_LDB(dst, b, h) do { _Pragma("unroll") for (int n = 0; n < 2; ++n) _Pragma("unroll") for (int k = 0; k < 2; ++k) dst[n][k] = *(const LAS bf16x8*)(lds + PG8_SB(b, h) + boff + n * 2048 + k * 1024); } while (0)
#define PG8_MMA(ai, bj, At, Bt) do { __builtin_amdgcn_s_setprio(1); _Pragma("unroll") for (int m = 0; m < 4; ++m) _Pragma("unroll") for (int n = 0; n < 2; ++n) _Pragma("unroll") for (int k = 0; k < 2; ++k) \
        acc[ai][bj][m][n] = __builtin_amdgcn_mfma_f32_16x16x32_bf16(Bt[n][k], At[m][k], acc[ai][bj][m][n], 0, 0, 0); __builtin_amdgcn_s_setprio(0); } while (0)
#define PG8_WAIT_V(n) asm volatile("s_waitcnt vmcnt(" #n ")" ::: "memory")
#define PG8_WAIT_L(n) asm volatile("s_waitcnt lgkmcnt(" #n ")" ::: "memory")
#define PG8_BAR __builtin_amdgcn_s_barrier()
#define PG8_SCHED __builtin_amdgcn_sched_barrier(0)
    Unit cur, nxt; int ui = 0;
    if (!S.next(0, cur)) return;
    f32x4 acc[2][2][4][2];
#pragma unroll
    for (int a = 0; a < 2; ++a)
#pragma unroll
        for (int b = 0; b < 2; ++b)
#pragma unroll
            for (int m = 0; m < 4; ++m)
#pragma unroll
                for (int n = 0; n < 2; ++n) acc[a][b][m][n] = (f32x4){0.f, 0.f, 0.f, 0.f};
    bf16x8 At[4][2], B0[2][2], B1[2][2];
    const char* cA = (const char*)g.A + (size_t)cur.pm * tstep; const char* cB = (const char*)g.Bt + (size_t)cur.pn * tstep;
    PG8_STAGE(PG8_SB(0, 0), cB, voffB); PG8_STAGE(PG8_SB(0, 1), cB + hstep, voffB); PG8_STAGE(PG8_SA(0, 0), cA, voffA); PG8_STAGE(PG8_SA(0, 1), cA + hstep, voffA);
    if (wr == 1) PG8_BAR;
    PG8_WAIT_V(2); PG8_BAR;
    PG8_STAGE(PG8_SB(1, 0), cB + kstep, voffB); PG8_STAGE(PG8_SA(1, 0), cA + kstep, voffA); PG8_STAGE(PG8_SB(1, 1), cB + hstep + kstep, voffB);
    PG8_WAIT_V(6); PG8_BAR;
    for (;;) {
        const bool has_next = S.next(ui + 1, nxt);
        const char* nA = has_next ? (const char*)g.A + (size_t)nxt.pm * tstep : cA; const char* nB = has_next ? (const char*)g.Bt + (size_t)nxt.pn * tstep : cB;
        for (int t = 0; t < nt; t += 2) {
            const bool last = (t == nt - 2);
            const char* a1 = cA + (size_t)(t + 1) * kstep;
            const char* a2 = last ? nA : cA + (size_t)(t + 2) * kstep; const char* b2 = last ? nB : cB + (size_t)(t + 2) * kstep;
            const char* a3 = a2 + kstep; const char* b3 = b2 + kstep;
            PG8_LDB(B0, 0, 0); PG8_LDB(B1, 0, 1); PG8_SCHED; PG8_LDA(At, 0, 0); PG8_STAGE(PG8_SA(1, 1), a1 + hstep, voffA);
            PG8_WAIT_V(8); PG8_WAIT_L(0); PG8_BAR; PG8_MMA(0, 0, At, B0); PG8_MMA(0, 1, At, B1); PG8_BAR; PG8_SCHED;
            PG8_LDA(At, 0, 1); PG8_STAGE(PG8_SB(0, 0), b2, voffB); PG8_STAGE(PG8_SB(0, 1), b2 + hstep, voffB); PG8_STAGE(PG8_SA(0, 0), a2, voffA);
            PG8_WAIT_V(8); PG8_WAIT_L(0); PG8_BAR; PG8_MMA(1, 0, At, B0); PG8_MMA(1, 1, At, B1); PG8_BAR; PG8_SCHED;
            PG8_LDB(B0, 1, 0); PG8_LDB(B1, 1, 1); PG8_SCHED; PG8_LDA(At, 1, 0); PG8_STAGE(PG8_SA(0, 1), a2 + hstep, voffA);
            PG8_WAIT_V(8); PG8_WAIT_L(0); PG8_BAR; PG8_MMA(0, 0, At, B0); PG8_MMA(0, 1, At, B1); PG8_BAR; PG8_SCHED;
            PG8_LDA(At, 1, 1); PG8_STAGE(PG8_SB(1, 0), b3, voffB); PG8_STAGE(PG8_SB(1, 1), b3 + hstep, voffB); PG8_STAGE(PG8_SA(1, 0), a3, voffA);
            PG8_WAIT_V(8); PG8_WAIT_L(0); PG8_BAR; PG8_MMA(1, 0, At, B0); PG8_MMA(1, 1, At, B1); PG8_BAR; PG8_SCHED;
        }
        if (wr == 0) PG8_BAR;
        E(acc, cur, wr, wc, fr, fq);
        if (!has_next) break;
#pragma unroll
        for (int a = 0; a < 2; ++a)
#pragma unroll
            for (int b = 0; b < 2; ++b)
#pragma unroll
                for (int m = 0; m < 4; ++m)
#pragma unroll
                    for (int n = 0; n < 2; ++n) acc[a][b][m][n] = (f32x4){0.f, 0.f, 0.f, 0.f};
        cur = nxt; cA = nA; cB = nB; ++ui;
        if (wr == 1) PG8_BAR;
    }
    PG8_WAIT_V(0);
    PG8_BAR;
#undef PG8_SA
#undef PG8_SB
#undef PG8_STAGE
#undef PG8_LDA
#undef PG8_LDB
#undef PG8_MMA
#undef PG8_WAIT_V
#undef PG8_WAIT_L
#undef PG8_BAR
#undef PG8_SCHED
}
}

__device__ __forceinline__ int rowmap(int map, int n) {
    if (map == 0) return n;
    const int half = map == 1 ? 1024 : FF;
    const int hi = n >= half ? 1 : 0, nn = n - hi * half;
    return 256 * (nn >> 7) + 128 * hi + (nn & 127);
}
__device__ __forceinline__ void transpose_item(const float* __restrict__ W, int K, int N, bf16_t* WT, int map, LAS float* scr, int item, int lane) {
    const int nblk = N / 32, kb = item / nblk, nb = item % nblk, k0 = 64 * kb, n0 = 32 * nb;
#pragma unroll 8
    for (int i = 0; i < 32; ++i) { const int kk = 2 * i + (lane >> 5); scr[kk * 33 + (lane & 31)] = W[(size_t)(k0 + kk) * N + n0 + (lane & 31)]; }
    LDS_FENCE();
    const int c = lane & 7;
#pragma unroll
    for (int j = 0; j < 4; ++j) { const int n = (lane >> 3) + 8 * j; const LAS float* s = scr + (8 * c) * 33 + n;
        u32x4 o; o.x = pk2(s[0 * 33], s[1 * 33]); o.y = pk2(s[2 * 33], s[3 * 33]); o.z = pk2(s[4 * 33], s[5 * 33]); o.w = pk2(s[6 * 33], s[7 * 33]);
        *(u32x4*)(WT + (size_t)rowmap(map, n0 + n) * K + k0 + 8 * c) = o; }
    LDS_FENCE();
}

__device__ __forceinline__ void phase0(KP P, LAS unsigned char* lds) {
    int tid = threadIdx.x; LAUNDER_TID(tid); int bid = blockIdx.x; LAUNDER_S(bid);
    const int lane = tid & 63, wave = tid >> 6;
    const int gw = bid * 8 + wave, NGW = gridDim.x * 8;
    unsigned char* ws = P->ws;
    LAS float* sc = (LAS float*)lds;
    const float* c = P->in[1];
    for (int i = tid; i < 32 * 1024; i += 512) { const float v = c[i]; sc[i] = v * sigmoidf_(v); }
    __syncthreads();
    {
        const float* w_ada = P->in[2]; const float* b_ada = P->in[3]; float* mod = (float*)(ws + WS_MOD);
        for (int col = gw; col < MODC; col += NGW) {
            float w[16];
#pragma unroll
            for (int i = 0; i < 16; ++i) w[i] = w_ada[(size_t)(lane + 64 * i) * MODC + col];
            float keep = 0.f;
            for (int b = 0; b < 32; ++b) {
                float s = 0.f;
#pragma unroll
                for (int i = 0; i < 16; ++i) s += sc[b * 1024 + lane + 64 * i] * w[i];
                s = wave_sum(s);
                keep = (lane == b) ? s : keep;
            }
            if (lane < 32) mod[(size_t)lane * MODC + col] = keep + b_ada[col];
        }
    }
    __syncthreads();
    {
        LAS float* scr = (LAS float*)(lds + wave * 8448);
        constexpr int I_IN = (1024 / 64) * (INC / 32), I_OR = (512 / 64) * (1024 / 32), I_GLU = (512 / 64) * (2048 / 32), I_OUT = (1024 / 64) * (1024 / 32),
                      I_UP = (1024 / 64) * (FF2 / 32), I_DN = (FF / 64) * (1024 / 32);
        constexpr int NITEMS = I_IN + I_OR + I_GLU + I_OUT + I_UP + I_DN;
        for (int it = gw; it < NITEMS; it += NGW) {
            int r = it;
            if (r < I_IN) { transpose_item(P->in[5], 1024, INC, (bf16_t*)(ws + WS_WIN), 0, scr, r, lane); continue; } r -= I_IN;
            if (r < I_OR) { transpose_item(P->in[17], 512, 1024, (bf16_t*)(ws + WS_WOR), 0, scr, r, lane); continue; } r -= I_OR;
            if (r < I_GLU) { transpose_item(P->in[26], 512, 2048, (bf16_t*)(ws + WS_WGLU), 1, scr, r, lane); continue; } r -= I_GLU;
            if (r < I_OUT) { transpose_item(P->in[27], 1024, 1024, (bf16_t*)(ws + WS_WOUT), 0, scr, r, lane); continue; } r -= I_OUT;
            if (r < I_UP) { transpose_item(P->in[29], 1024, FF2, (bf16_t*)(ws + WS_WUP), 2, scr, r, lane); continue; } r -= I_UP;
            transpose_item(P->in[32], FF, 1024, (bf16_t*)(ws + WS_WDN), 0, scr, r, lane);
        }
    }
    {
        bf16_t* wl = (bf16_t*)(ws + WS_WLORA);
        const float* w_up = P->in[8]; const float* a_up = P->in[10]; const float* g_up = P->in[11];
        for (int idx = bid * 512 + tid; idx < 1536 * 256; idx += gridDim.x * 512) {
            const int n = idx >> 8, k = idx & 255, which = n >> 9, nn = n & 511;
            float v = 0.f;
            if (which == 0) { if (k < 64) v = w_up[k * 512 + nn]; }
            else if (which == 1) { if (k >= 64 && k < 128) v = a_up[(k - 64) * 512 + nn]; }
            else { if (k >= 128) v = g_up[(k - 128) * 512 + nn]; }
            wl[idx] = (bf16_t)f2bf(v);
        }
    }
}

template <int MODE>
__device__ __forceinline__ void phase_norm(const float* X, const bf16_t* dl, const bf16_t* dl2, const float* g, const float* mod, int sh_off, int sc_off, bf16_t* outb, float* outf) {
    int tid = threadIdx.x; LAUNDER_TID(tid); int bid = blockIdx.x; LAUNDER_S(bid);
    const int lane = tid & 63, wave = tid >> 6;
    const int gw = bid * 8 + wave, NGW = gridDim.x * 8;
    f32x4 gg[4];
#pragma unroll
    for (int j = 0; j < 4; ++j) gg[j] = *(const f32x4*)(g + lane * 4 + 256 * j);
    for (int rp = gw; rp < T_ / 2; rp += NGW) {
        f32x4 v[2][4]; u32x2 dw[2][4], dw2[2][4];
#pragma unroll
        for (int r = 0; r < 2; ++r) {
            const size_t row = (size_t)(2 * rp + r);
            const f32x4* xr = (const f32x4*)(X + row * 1024) + lane;
#pragma unroll
            for (int j = 0; j < 4; ++j) v[r][j] = xr[64 * j];
            if (MODE != 0) {
#pragma unroll
                for (int j = 0; j < 4; ++j) dw[r][j] = *(const u32x2*)(dl + row * 1024 + lane * 4 + 256 * j);
            }
            if (MODE == 1) {
#pragma unroll
                for (int j = 0; j < 4; ++j) dw2[r][j] = *(const u32x2*)(dl2 + row * 1024 + lane * 4 + 256 * j);
            }
        }
#pragma unroll
        for (int r = 0; r < 2; ++r) {
            const size_t row = (size_t)(2 * rp + r);
            float ss = 0.f;
#pragma unroll
            for (int j = 0; j < 4; ++j) {
                if (MODE != 0) { v[r][j].x += bflo(dw[r][j].x); v[r][j].y += bfhi(dw[r][j].x); v[r][j].z += bflo(dw[r][j].y); v[r][j].w += bfhi(dw[r][j].y); }
                if (MODE == 1) { v[r][j].x += bflo(dw2[r][j].x); v[r][j].y += bfhi(dw2[r][j].x); v[r][j].z += bflo(dw2[r][j].y); v[r][j].w += bfhi(dw2[r][j].y); }
                ss += (v[r][j].x * v[r][j].x + v[r][j].y * v[r][j].y) + (v[r][j].z * v[r][j].z + v[r][j].w * v[r][j].w);
            }
            ss = wave_sum(ss);
            const float inv = rsqrtf(ss * (1.0f / 1024.0f) + 1e-6f);
            if (MODE != 1) {
                const int b = (int)(row >> 11);
#pragma unroll
                for (int j = 0; j < 4; ++j) { const int col = lane * 4 + 256 * j;
                    const f32x4 sc = *(const f32x4*)(mod + (size_t)b * MODC + sc_off + col), sh = *(const f32x4*)(mod + (size_t)b * MODC + sh_off + col);
                    const f32x4 o = v[r][j] * inv * gg[j] * (sc + 1.0f) + sh;
                    u32x2 w; w.x = pk2(o.x, o.y); w.y = pk2(o.z, o.w);
                    *(u32x2*)(outb + row * 1024 + col) = w;
                    }
            } else {
#pragma unroll
                for (int j = 0; j < 4; ++j) { const int col = lane * 4 + 256 * j;
                    *(f32x4*)(outf + row * 1024 + col) = v[r][j] * inv * gg[j]; }
            }
        }
    }
}

__device__ __forceinline__ float gelu_tanh(float x) {
    const float u = 0.7978845608f * (x + 0.044715f * x * x * x);
    const float e = __expf(2.0f * u);
    const float t = 1.0f - 2.0f * __builtin_amdgcn_rcpf(1.0f + e);
    return 0.5f * x * (1.0f + t);
}
__device__ __forceinline__ void s5_q(const float* a_re, const float* a_im, float dt, int idx, float& qre, float& qim) {
    const float are = a_re[idx], aim = a_im[idx];
    const float zre = are * dt, zim = aim * dt, mag = expf(zre);
    const float abre = mag * cosf(zim), abim = mag * sinf(zim);
    const float den = are * are + aim * aim;
    qre = ((abre - 1.0f) * are + abim * aim) / den;
    qim = (abim * are - (abre - 1.0f) * aim) / den;
}
struct S5Regs { bf16x8 af; float ar, ai, dval, xr, xi; size_t ubase; };
__device__ __forceinline__ void s5_setup(KP P, int b, int g, int lane, S5Regs& R, LAS bf16_t* BB) {
    const bf16_t* U = (const bf16_t*)(P->ws + WS_U5);
    const int l15 = lane & 15, quad = lane >> 4;
    const float dt = expf(P->in[20][g]);
    { const float are = P->in[18][g * 64 + lane], aim = P->in[19][g * 64 + lane]; const float mag = expf(are * dt); R.ar = mag * cosf(aim * dt); R.ai = mag * sinf(aim * dt); }
#pragma unroll
    for (int pt = 0; pt < 4; ++pt) {
        const int pp = pt * 16 + l15;
        float qre, qim; s5_q(P->in[18], P->in[19], dt, g * 64 + pp, qre, qim);
        bf16x8 fre, fim;
#pragma unroll
        for (int j = 0; j < 8; ++j) {
            float vre = 0.f, vim = 0.f;
            if (quad < 2) { const int cidx = (g * 64 + pp) * 16 + quad * 8 + j; const float bre = P->in[21][cidx], bim = P->in[22][cidx];
                vre = qre * bre - qim * bim; vim = qre * bim + qim * bre; }
            fre[j] = (short)f2bf(vre); fim[j] = (short)f2bf(vim);
        }
        if (quad < 2) { *(LAS bf16x8*)(BB + (pp) * 16 + quad * 8) = fre; *(LAS bf16x8*)(BB + (64 + pp) * 16 + quad * 8) = fim; }
    }
#pragma unroll
    for (int kk = 0; kk < 4; ++kk) {
        bf16x8 f;
#pragma unroll
        for (int j = 0; j < 8; ++j) { const int k = kk * 32 + quad * 8 + j;
            const float v = k < 64 ? P->in[23][(g * 16 + l15) * 64 + k] : -P->in[24][(g * 16 + l15) * 64 + (k - 64)];
            f[j] = (short)f2bf(v); }
        *(LAS bf16x8*)(BB + 128 * 16 + l15 * 128 + kk * 32 + quad * 8) = f;
    }
    R.dval = P->in[25][g * 16 + l15];
    R.xr = 0.f; R.xi = 0.f;
    R.ubase = (size_t)b * SQ * 512 + g * 16;
    R.af = (bf16x8){0, 0, 0, 0, 0, 0, 0, 0};
    if (quad < 2) R.af = *(const bf16x8*)(U + R.ubase + (size_t)l15 * 512 + quad * 8);
}
__device__ __forceinline__ void s5_chunk(KP P, S5Regs& R, int ck, LAS float* BU, LAS bf16_t* XB, const LAS bf16_t* BB, int lane) {
    bf16_t* U = (bf16_t*)(P->ws + WS_U5);
    const int l15 = lane & 15, quad = lane >> 4;
    const int t0 = ck * 16;
    bf16x8 afn = (bf16x8){0, 0, 0, 0, 0, 0, 0, 0};
    if (quad < 2 && ck + 1 < SQ / 16) afn = *(const bf16x8*)(U + R.ubase + (size_t)(t0 + 16 + l15) * 512 + quad * 8);
    float uo[4];
#pragma unroll
    for (int j = 0; j < 4; ++j) uo[j] = bf2f(U[R.ubase + (size_t)(t0 + quad * 4 + j) * 512 + l15]);
#pragma unroll
    for (int q = 0; q < 8; ++q) {
        const bf16x8 bq = *(const LAS bf16x8*)(BB + (q * 16 + l15) * 16 + (quad & 1) * 8);
        f32x4 d = __builtin_amdgcn_mfma_f32_16x16x32_bf16(R.af, bq, (f32x4){0.f, 0.f, 0.f, 0.f}, 0, 0, 0);
#pragma unroll
        for (int j = 0; j < 4; ++j) BU[(quad * 4 + j) * 128 + q * 16 + l15] = d[j];
    }
    LDS_FENCE();
    float xr = R.xr, xi = R.xi;
#pragma unroll
    for (int tt = 0; tt < 16; ++tt) {
        const float bre = BU[tt * 128 + lane], bim = BU[tt * 128 + 64 + lane];
        const float nr = R.ar * xr - R.ai * xi + bre, ni = R.ar * xi + R.ai * xr + bim;
        xr = nr; xi = ni;
        XB[tt * 136 + lane] = (bf16_t)f2bf(xr); XB[tt * 136 + 64 + lane] = (bf16_t)f2bf(xi);
    }
    R.xr = xr; R.xi = xi;
    LDS_FENCE();
    f32x4 y = (f32x4){0.f, 0.f, 0.f, 0.f};
#pragma unroll
    for (int kk = 0; kk < 4; ++kk) {
        const bf16x8 a2 = *(const LAS bf16x8*)(XB + l15 * 136 + kk * 32 + quad * 8);
        const bf16x8 cmk = *(const LAS bf16x8*)(BB + 128 * 16 + l15 * 128 + kk * 32 + quad * 8);
        y = __builtin_amdgcn_mfma_f32_16x16x32_bf16(a2, cmk, y, 0, 0, 0);
    }
#pragma unroll
    for (int j = 0; j < 4; ++j) {
        const float yv = y[j] + R.dval * uo[j];
        U[R.ubase + (size_t)(t0 + quad * 4 + j) * 512 + l15] = (bf16_t)f2bf(gelu_tanh(yv));
    }
    LDS_FENCE();
    R.af = afn;
}
__device__ __forceinline__ void phase_lora_in(KP P, bool own_panel) {
    int tid = threadIdx.x; LAUNDER_TID(tid); int bid = blockIdx.x; LAUNDER_S(bid);
    const int lane = tid & 63, wave = tid >> 6;
    unsigned char* ws = P->ws;
    const bf16_t* PR = (const bf16_t*)(ws + WS_PR); bf16_t* LIN = (bf16_t*)(ws + WS_LIN);
    const f32x4 mu = *(const f32x4*)(P->in[6] + 1536 + lane * 4);
    const int r_lo = own_panel ? bid * 256 + wave : bid * 8 + wave, r_hi = own_panel ? bid * 256 + 256 : T_, r_st = own_panel ? 8 : (int)gridDim.x * 8;
    for (int row = r_lo; row < r_hi; row += r_st) {
        const u32x2 cw = *(const u32x2*)(PR + (size_t)row * SHC + 1536 + lane * 4);
        u32x2 pw; pw.x = 0u; pw.y = 0u;
        if ((row & (SQ - 1)) != 0) pw = *(const u32x2*)(PR + (size_t)(row - 1) * SHC + 1536 + lane * 4);
        float cv[4] = {bflo(cw.x), bfhi(cw.x), bflo(cw.y), bfhi(cw.y)}, pv[4] = {bflo(pw.x), bfhi(pw.x), bflo(pw.y), bfhi(pw.y)};
        const float muv[4] = {mu.x, mu.y, mu.z, mu.w};
        float o[4];
#pragma unroll
        for (int i = 0; i < 4; ++i) {
            const float p = cv[i] + (pv[i] - cv[i]) * muv[i];
            const float th = 1.0f - 2.0f * __builtin_amdgcn_rcpf(1.0f + __expf(2.0f * p));
            const float sg = sigmoidf_(p);
            o[i] = lane < 16 ? th : (lane < 32 ? p : sg);
        }
        u32x2 w; w.x = pk2(o[0], o[1]); w.y = pk2(o[2], o[3]);
        *(u32x2*)(LIN + (size_t)row * 256 + lane * 4) = w;
    }
}

constexpr int RW_CH = 16;
constexpr int RW_OPS = 5 * RW_CH * 64 * 4;
constexpr int RW_VC = RW_CH * 64 * 4 + 256;
constexpr int RW_VCOFF = 2 * RW_OPS;
constexpr int RW_YOFF = RW_VCOFF + 3 * RW_VC;
constexpr int RW_S5OFF = RW_YOFF + 2 * RW_CH * 64 * 4;
constexpr int S5_WB = 8192 + 4352 + 4096 + 4096;
static_assert(RW_S5OFF + 4 * S5_WB <= LDS_BARW, "rwkv lds");

struct RwConst { float mur, muk, muv, kkw, kaw, rkw, w0c, a0c, lg, lb; };
struct RwPrepLd { float cr[4], ck[4], cv[4], pr[4], pk[4], pv[4], e[4], a[4]; };
__device__ __forceinline__ void rw_const(KP P, int h, int lane, RwConst& C) {
    const int ch = h * 64 + lane;
    C.mur = P->in[6][ch]; C.muk = P->in[6][512 + ch]; C.muv = P->in[6][1024 + ch];
    C.kkw = P->in[12][ch]; C.kaw = P->in[13][ch]; C.rkw = P->in[14][ch]; C.w0c = P->in[7][ch]; C.a0c = P->in[9][ch];
    C.lg = P->in[15][ch]; C.lb = P->in[16][ch];
}
__device__ __forceinline__ void rw_prep_load(KP P, int b, int h, int chunk, int wl, int lane, RwPrepLd& L) {
    const unsigned char* ws = P->ws;
    const bf16_t* PR = (const bf16_t*)(ws + WS_PR); const bf16_t* E = (const bf16_t*)(ws + WS_E); const bf16_t* AA = (const bf16_t*)(ws + WS_AA);
    const int ch = h * 64 + lane;
#pragma unroll
    for (int i = 0; i < RW_CH / 4; ++i) {
        const int tt = wl + 4 * i, s = chunk * RW_CH + tt; const size_t row = (size_t)b * SQ + s;
        L.cr[i] = bf2f(PR[row * SHC + ch]); L.ck[i] = bf2f(PR[row * SHC + 512 + ch]); L.cv[i] = bf2f(PR[row * SHC + 1024 + ch]);
        const size_t prow = s > 0 ? row - 1 : row;
        L.pr[i] = bf2f(PR[prow * SHC + ch]); L.pk[i] = bf2f(PR[prow * SHC + 512 + ch]); L.pv[i] = bf2f(PR[prow * SHC + 1024 + ch]);
        L.e[i] = bf2f(E[row * 512 + ch]); L.a[i] = bf2f(AA[row * 512 + ch]);
    }
}
__device__ __forceinline__ void rw_prep_compute(LAS unsigned char* opsp, LAS unsigned char* vcp, const RwConst& C, const RwPrepLd& L, int chunk, int wl, int lane) {
    LAS float* Wb = (LAS float*)opsp; LAS float* Ab = Wb + RW_CH * 64; LAS float* Bb = Ab + RW_CH * 64; LAS float* Kb = Bb + RW_CH * 64; LAS float* Rb = Kb + RW_CH * 64; LAS float* Vb = (LAS float*)vcp;
    LAS float* Cf = Vb + RW_CH * 64;
#pragma unroll
    for (int i = 0; i < RW_CH / 4; ++i) {
        const int tt = wl + 4 * i, s = chunk * RW_CH + tt;
        const float pr = s > 0 ? L.pr[i] : 0.f, pk = s > 0 ? L.pk[i] : 0.f, pv = s > 0 ? L.pv[i] : 0.f;
        const float r = L.cr[i] + (pr - L.cr[i]) * C.mur, k = L.ck[i] + (pk - L.ck[i]) * C.muk, v = L.cv[i] + (pv - L.cv[i]) * C.muv;
        const float w = exp2f(-0.87504106f * sigmoidf_(C.w0c + L.e[i]));
        const float a = sigmoidf_(C.a0c + L.a[i]);
        float kk = k * C.kkw;
        const float ss = wave_sum(kk * kk);
        kk *= rsqrtf(ss + 1e-12f);
        const float kmod = k * (1.0f + (a - 1.0f) * C.kaw);
        const float coef = wave_sum(r * kmod * C.rkw);
        Wb[tt * 64 + lane] = w; Ab[tt * 64 + lane] = -kk; Bb[tt * 64 + lane] = kk * a; Kb[tt * 64 + lane] = kmod; Rb[tt * 64 + lane] = r; Vb[tt * 64 + lane] = v;
        if (lane == 0) Cf[tt] = coef;
    }
}
__device__ __forceinline__ void rw_post_load(KP P, int b, int h, int chunk, int wl, int lane, float (&g)[4]) {
    const bf16_t* GG = (const bf16_t*)(P->ws + WS_GG);
    const int ch = h * 64 + lane;
#pragma unroll
    for (int i = 0; i < 4; ++i) { const size_t row = (size_t)b * SQ + chunk * RW_CH + wl + 4 * i; g[i] = bf2f(GG[row * 512 + ch]); }
}
__device__ __forceinline__ void rw_post_compute(KP P, LAS unsigned char* vcp, LAS float* yb, const RwConst& C, const float (&g)[4], int b, int h, int chunk, int wl, int lane) {
    bf16_t* YR = (bf16_t*)(P->ws + WS_YR);
    const int ch = h * 64 + lane;
    LAS float* Vb = (LAS float*)vcp; LAS float* Cf = Vb + RW_CH * 64;
#pragma unroll
    for (int i = 0; i < 4; ++i) {
        const int tt = wl + 4 * i;
        const size_t row = (size_t)b * SQ + chunk * RW_CH + tt;
        const float y = yb[tt * 64 + lane];
        const float mean = wave_sum(y) * (1.0f / 64.0f);
        const float d = y - mean;
        const float var = wave_sum(d * d) * (1.0f / 64.0f);
        const float yn = d * rsqrtf(var + 64e-5f) * C.lg + C.lb;
        YR[row * 512 + ch] = (bf16_t)f2bf((yn + Cf[tt] * Vb[tt * 64 + lane]) * g[i]);
    }
}
__device__ __forceinline__ float dpp_xor1(float v) { return __int_as_float(__builtin_amdgcn_update_dpp(0, __float_as_int(v), 0xB1, 0xF, 0xF, false)); }
__device__ __forceinline__ float dpp_hmirror(float v) { return __int_as_float(__builtin_amdgcn_update_dpp(0, __float_as_int(v), 0x141, 0xF, 0xF, false)); }
__device__ __forceinline__ float dpp_xor2(float v) { return __int_as_float(__builtin_amdgcn_update_dpp(0, __float_as_int(v), 0x4E, 0xF, 0xF, false)); }
__device__ __forceinline__ void phase_rwkv(KP P, LAS unsigned char* lds, bool do_s5) {
    int tid = threadIdx.x; LAUNDER_TID(tid); int bid = blockIdx.x; LAUNDER_S(bid);
    const int lane = tid & 63, wave = __builtin_amdgcn_readfirstlane(tid >> 6);
    constexpr int NCH = SQ / RW_CH;
    for (int bh = bid; bh < 256; bh += gridDim.x) {
        const int b = bh >> 3, h = bh & 7;
        f32x4 S0[2], S1[2];
#pragma unroll
        for (int k = 0; k < 2; ++k) { S0[k] = (f32x4){0.f, 0.f, 0.f, 0.f}; S1[k] = (f32x4){0.f, 0.f, 0.f, 0.f}; }
        const bool helper = wave >= 4;
        const int hj = wave & 3;
        S5Regs R5;
        LAS float* BU5 = (LAS float*)(lds + RW_S5OFF + hj * S5_WB); LAS bf16_t* XB5 = (LAS bf16_t*)(lds + RW_S5OFF + hj * S5_WB + 8192); LAS bf16_t* BB5 = (LAS bf16_t*)(lds + RW_S5OFF + hj * S5_WB + 8192 + 4352);
        RwConst RC; RwPrepLd RL; float gq[4] = {0.f, 0.f, 0.f, 0.f};
        if (helper) { const int chain = bh * 4 + hj; s5_setup(P, chain >> 5, chain & 31, lane, R5, BB5); rw_const(P, h, lane, RC); rw_prep_load(P, b, h, 0, hj, lane, RL); rw_prep_compute(lds, lds + RW_VCOFF, RC, RL, 0, hj, lane); }
        __syncthreads();
        for (int c = 0; c < NCH; ++c) {
            if (!helper) {
                const int ko = lane & 7, rowv = 16 * wave + 2 * (lane >> 3);
                LAS unsigned char* bufp = lds + (c & 1) * RW_OPS;
                const LAS f32x4* W4 = (const LAS f32x4*)bufp + ko * 2; const LAS f32x4* A4 = W4 + RW_CH * 16; const LAS f32x4* B4 = A4 + RW_CH * 16; const LAS f32x4* K4 = B4 + RW_CH * 16; const LAS f32x4* R4 = K4 + RW_CH * 16;
                const LAS f32x2* Vb2 = (const LAS f32x2*)((const LAS float*)(lds + RW_VCOFF + (c % 3) * RW_VC) + rowv);
                LAS f32x2* yb2 = (LAS f32x2*)((LAS float*)(lds + RW_YOFF) + (c & 1) * RW_CH * 64 + rowv);
                f32x4 a[2][2]; f32x2 vv[2];
                f32x4 ew[2][2], eb[2][2], ek[2][2], er[2][2];
                auto issue = [&](int t, int g) {
                    const int p = t & 1, ta = t & (RW_CH - 1);
                    if (g == 0) {
                        a[p][0] = A4[ta * 16]; a[p][1] = A4[ta * 16 + 1];
                        vv[p] = Vb2[ta * 32];
                    } else {
                        const int e = g - 1, o = ta * 16 + e;
                        ew[p][e] = W4[o]; eb[p][e] = B4[o]; ek[p][e] = K4[o]; er[p][e] = R4[o];
                    }
                };
                issue(0, 0); issue(0, 1); issue(0, 2);
#pragma unroll
                for (int tt = 0; tt < RW_CH; ++tt) {
                    const int p = tt & 1;
                    __builtin_amdgcn_sched_barrier(0); issue(tt + 1, 0); __builtin_amdgcn_sched_barrier(0);
                    const float v0 = vv[p].x, v1 = vv[p].y;
                    const f32x4 q0 = S0[0] * a[p][0] + S0[1] * a[p][1], q1 = S1[0] * a[p][0] + S1[1] * a[p][1];
                    float sa0 = (q0.x + q0.y) + (q0.z + q0.w), sa1 = (q1.x + q1.y) + (q1.z + q1.w);
                    sa0 += dpp_xor1(sa0); sa1 += dpp_xor1(sa1); sa0 += dpp_xor2(sa0); sa1 += dpp_xor2(sa1); sa0 += dpp_hmirror(sa0); sa1 += dpp_hmirror(sa1);
                    f32x4 y0 = (f32x4){0.f, 0.f, 0.f, 0.f}, y1 = (f32x4){0.f, 0.f, 0.f, 0.f};
#pragma unroll
                    for (int e = 0; e < 2; ++e) {
                        __builtin_amdgcn_sched_barrier(0); issue(tt + 1, 1 + e); __builtin_amdgcn_sched_barrier(0);
                        S0[e] = S0[e] * ew[p][e] + (eb[p][e] * sa0 + ek[p][e] * v0); y0 += S0[e] * er[p][e];
                        S1[e] = S1[e] * ew[p][e] + (eb[p][e] * sa1 + ek[p][e] * v1); y1 += S1[e] * er[p][e];
                    }
                    __builtin_amdgcn_sched_barrier(0);
                    float r0 = (y0.x + y0.y) + (y0.z + y0.w), r1 = (y1.x + y1.y) + (y1.z + y1.w);
                    r0 += dpp_xor1(r0); r1 += dpp_xor1(r1); r0 += dpp_xor2(r0); r1 += dpp_xor2(r1); r0 += dpp_hmirror(r0); r1 += dpp_hmirror(r1);
                    yb2[tt * 32] = (f32x2){r0, r1};
                }
            } else {
                if (c + 1 < NCH) rw_prep_load(P, b, h, c + 1, hj, lane, RL);
                if (c >= 1) rw_post_load(P, b, h, c - 1, hj, lane, gq);
                if (do_s5) s5_chunk(P, R5, c, BU5, XB5, BB5, lane);
                if (c + 1 < NCH) rw_prep_compute(lds + ((c + 1) & 1) * RW_OPS, lds + RW_VCOFF + ((c + 1) % 3) * RW_VC, RC, RL, c + 1, hj, lane);
                if (c >= 1) rw_post_compute(P, lds + RW_VCOFF + ((c - 1) % 3) * RW_VC, (LAS float*)(lds + RW_YOFF) + ((c - 1) & 1) * RW_CH * 64, RC, gq, b, h, c - 1, hj, lane);
            }
            __syncthreads();
        }
        if (helper) { rw_post_load(P, b, h, NCH - 1, hj, lane, gq); rw_post_compute(P, lds + RW_VCOFF + ((NCH - 1) % 3) * RW_VC, (LAS float*)(lds + RW_YOFF) + ((NCH - 1) & 1) * RW_CH * 64, RC, gq, b, h, NCH - 1, hj, lane); }
        __syncthreads();
    }
}

__device__ __forceinline__ void phase_fixup(KP P) {
    const bf16_t* HALO = (const bf16_t*)(P->ws + WS_HALO); bf16_t* ACT = (bf16_t*)(P->ws + WS_ACT);
    const float* cw = P->in[30]; const float* cb = P->in[31];
    constexpr int NCG = FF / 8, NITEM = (T_ / 64) * NCG;
    int tid = threadIdx.x; LAUNDER_TID(tid); int bid = blockIdx.x; LAUNDER_S(bid);
    for (int it = bid * 512 + tid; it < NITEM; it += gridDim.x * 512) {
        const int cg8 = it % NCG, blk = it / NCG;
        const int oc = cg8 * 8, pn = oc >> 7, j0 = oc & 127;
        const int hg = 256 * pn + j0, hu = hg + 128;
        const bool first = ((blk * 64) & (SQ - 1)) == 0;
        float g[4][8], uu[4][8];
#pragma unroll
        for (int r = 0; r < 4; ++r) {
            const bool z = first && r < 2;
            const size_t hrow = r < 2 ? ((size_t)(z ? blk : blk - 1) * 4 + 2 + r) : ((size_t)blk * 4 + (r - 2));
            const u32x4 a = *(const u32x4*)(HALO + hrow * FF2 + hg), b = *(const u32x4*)(HALO + hrow * FF2 + hu);
            g[r][0] = bflo(a.x); g[r][1] = bfhi(a.x); g[r][2] = bflo(a.y); g[r][3] = bfhi(a.y); g[r][4] = bflo(a.z); g[r][5] = bfhi(a.z); g[r][6] = bflo(a.w); g[r][7] = bfhi(a.w);
            uu[r][0] = bflo(b.x); uu[r][1] = bfhi(b.x); uu[r][2] = bflo(b.y); uu[r][3] = bfhi(b.y); uu[r][4] = bflo(b.z); uu[r][5] = bfhi(b.z); uu[r][6] = bflo(b.w); uu[r][7] = bfhi(b.w);
            if (z) {
#pragma unroll
                for (int i = 0; i < 8; ++i) { g[r][i] = 0.f; uu[r][i] = 0.f; }
            }
        }
#pragma unroll
        for (int rr = 0; rr < 2; ++rr) {
            float o[8];
#pragma unroll
            for (int i = 0; i < 8; ++i) {
                const float gv = cb[oc + i] + cw[oc + i] * g[rr][i] + cw[FF2 + oc + i] * g[rr + 1][i] + cw[2 * FF2 + oc + i] * g[rr + 2][i];
                const float uv = cb[FF + oc + i] + cw[FF + oc + i] * uu[rr][i] + cw[FF2 + FF + oc + i] * uu[rr + 1][i] + cw[2 * FF2 + FF + oc + i] * uu[rr + 2][i];
                o[i] = gv * sigmoidf_(gv) * uv;
            }
            u32x4 ow; ow.x = pk2(o[0], o[1]); ow.y = pk2(o[2], o[3]); ow.z = pk2(o[4], o[5]); ow.w = pk2(o[6], o[7]);
            *(u32x4*)(ACT + ((size_t)blk * 64 + rr) * FF + oc) = ow;
        }
    }
}

__global__ void __launch_bounds__(512, 2) mk_fwd(Params Pv) {
    extern __shared__ __attribute__((aligned(16))) unsigned char shm[];
    LAS unsigned char* lds = (LAS unsigned char*)shm;
    cg::grid_group grid = cg::this_grid();
    const int ph_lo = Pv.ph_lo, ph_hi = Pv.ph_hi;
    volatile LAS unsigned* bst = (volatile LAS unsigned*)(lds + LDS_BARW);
    if (threadIdx.x == 0) { bst[0] = 0u; bst[1] = 0u; }
    __syncthreads();
    const XcdBarrier xbar = xcd_barrier_post((unsigned*)(Pv.ws + WS_CTL), bst);
    for (int phx = ph_lo; phx < ph_hi + (DUP_PHASE >= 0 ? 1 : 0); ++phx) {
        const int ph = (DUP_PHASE >= 0 && phx > DUP_PHASE) ? phx - 1 : phx;
        const bool rep = (DUP_PHASE >= 0 && phx == DUP_PHASE + 1);
        if (phx == ph_lo + 1) grid.sync();
        else if (phx > ph_lo && !(ph == 4 && (int)gridDim.x * 256 == T_ && DUP_PHASE < 0)) xcd_barrier(xbar);
        KP P = (KP)__builtin_amdgcn_kernarg_segment_ptr(); LAUNDER_S(P);
        unsigned char* ws = P->ws;
        float* mod = (float*)(ws + WS_MOD);
        pg8::Gemm g; pg8::Epi E; bool is_gemm = true;
        g.A = nullptr; g.Bt = nullptr; g.M = T_; g.N = 0; g.K = 1024; g.permA = 0;
        E.mode = 0; E.c1 = E.c2 = 1 << 30; E.ld0 = E.ld1 = E.ld2 = 0; E.sig2 = 0; E.o0 = E.o1 = E.o2 = nullptr; E.gates = (const bf16_t*)P->out; E.gatev = nullptr; E.cw = E.cb = nullptr;
        switch (ph) {
        case 2: g.A = (const bf16_t*)(ws + WS_HB); g.Bt = (const bf16_t*)(ws + WS_WIN); g.N = INC; g.K = 1024;
                E.mode = pg8::M_ROUTE; E.c1 = SHC; E.c2 = SHC + 512; E.ld0 = SHC; E.ld1 = 512; E.ld2 = 2048; E.sig2 = 1; E.o0 = (bf16_t*)(ws + WS_PR); E.o1 = (bf16_t*)(ws + WS_U5); E.o2 = (bf16_t*)P->out; break;
        case 4: g.A = (const bf16_t*)(ws + WS_LIN); g.Bt = (const bf16_t*)(ws + WS_WLORA); g.N = 1536; g.K = 256;
                E.mode = pg8::M_ROUTE; E.c1 = 512; E.c2 = 1024; E.ld0 = E.ld1 = E.ld2 = 512; E.o0 = (bf16_t*)(ws + WS_E); E.o1 = (bf16_t*)(ws + WS_AA); E.o2 = (bf16_t*)(ws + WS_GG); break;
        case 6: g.A = (const bf16_t*)(ws + WS_U5); g.Bt = (const bf16_t*)(ws + WS_WGLU); g.N = 2048; g.K = 512;
                E.mode = pg8::M_GLU; E.o0 = (bf16_t*)(ws + WS_HB); break;
        case 7: g.A = (const bf16_t*)(ws + WS_YR); g.Bt = (const bf16_t*)(ws + WS_WOR); g.N = 1024; g.K = 512;
                E.mode = pg8::M_MIXADD; E.o0 = (bf16_t*)(ws + WS_HB); break;
        case 8: g.A = (const bf16_t*)(ws + WS_HB); g.Bt = (const bf16_t*)(ws + WS_WOUT); g.N = 1024; g.K = 1024;
                E.mode = pg8::M_SCALE; E.o0 = (bf16_t*)(ws + WS_D1); E.gatev = mod + 2048; break;
        case 10: g.A = (const bf16_t*)(ws + WS_HB); g.Bt = (const bf16_t*)(ws + WS_WUP); g.N = FF2; g.K = 1024; g.permA = 1;
                E.mode = pg8::M_CONV; E.o0 = (bf16_t*)(ws + WS_ACT); E.o1 = (bf16_t*)(ws + WS_HALO); E.cw = P->in[30]; E.cb = P->in[31]; break;
        case 12: g.A = (const bf16_t*)(ws + WS_ACT); g.Bt = (const bf16_t*)(ws + WS_WDN); g.N = 1024; g.K = FF;
                E.mode = pg8::M_SCALE; E.o0 = (bf16_t*)(ws + WS_HB); E.gatev = mod + 5120; break;
        default: is_gemm = false; break;
        }
        if (is_gemm && (PHM & 4u)) {
            int bid = blockIdx.x; LAUNDER_S(bid);
            const bool fuse_lin = (ph == 4) && ((int)gridDim.x * 256 == T_);
            if (fuse_lin) { phase_lora_in(P, true); asm volatile("s_waitcnt vmcnt(0)" ::: "memory"); __syncthreads(); }
            pg8::StaticOrder S; S.init(g.M, g.N, (int)gridDim.x, bid, fuse_lin ? 1 : 0);
            pg8::gemm_phase(lds, g, S, E);
        } else if (ph == 0 && (PHM & 1u)) {
            phase0(P, lds);
        } else if (ph == 1 && (PHM & 2u)) {
            phase_norm<0>(P->in[0], nullptr, nullptr, P->in[4], mod, 0, 1024, (bf16_t*)(ws + WS_HB), nullptr);
        } else if (ph == 3 && (PHM & 8u)) {
            if ((int)gridDim.x * 256 != T_) phase_lora_in(P, false);
        } else if (ph == 5 && (PHM & 32u)) {
            phase_rwkv(P, lds, !rep);
        } else if (ph == 9 && (PHM & 2u)) {
            phase_norm<2>(P->in[0], (const bf16_t*)(ws + WS_D1), nullptr, P->in[28], mod, 3072, 4096, (bf16_t*)(ws + WS_HB), nullptr);
        } else if (ph == 11 && (PHM & 2048u)) {
            phase_fixup(P);
        } else if (ph == 13 && (PHM & 2u)) {
            phase_norm<1>(P->in[0], (const bf16_t*)(ws + WS_D1), (const bf16_t*)(ws + WS_HB), P->in[33], nullptr, 0, 0, nullptr, P->out);
        }
    }
}

extern "C" void kernel_launch(void* const* d_in, const int* in_sizes, int n_in, void* d_out, int out_size, void* d_ws, size_t ws_size, hipStream_t stream) {
    static int grid = 0;
    if (grid == 0) {
        if (n_in != 34 || in_sizes[0] != T_ * D_ || out_size != T_ * D_ || ws_size < WS_END) {
            fprintf(stderr, "kernel_launch: unexpected shapes: n_in %d in0 %d out %d ws %zu (need %zu)\n", n_in, n_in > 0 ? in_sizes[0] : -1, out_size, ws_size, (size_t)WS_END);
            grid = -1; return; }
        int dev = 0, cus = 0, per_cu = 0;
        (void)hipGetDevice(&dev);
        (void)hipDeviceGetAttribute(&cus, hipDeviceAttributeMultiprocessorCount, dev);
        if (hipFuncSetAttribute((const void*)mk_fwd, hipFuncAttributeMaxDynamicSharedMemorySize, LDS_BYTES) != hipSuccess) fprintf(stderr, "kernel_launch: hipFuncSetAttribute failed\n");
        if (hipOccupancyMaxActiveBlocksPerMultiprocessor(&per_cu, (const void*)mk_fwd, 512, LDS_BYTES) != hipSuccess || per_cu < 1) { fprintf(stderr, "kernel_launch: occupancy query gave %d\n", per_cu); per_cu = 1; }
        (void)hipGetLastError();
        if (cus <= 0) cus = 256;
        grid = cus;
    }
    if (grid < 0) return;
    (void)hipMemsetAsync((char*)d_ws + WS_CTL, 0, XCD_BAR_WORDS * 4, stream);
    Params p{};
    for (int i = 0; i < 34; ++i) p.in[i] = (const float*)d_in[i];
    p.out = (float*)d_out; p.ws = (unsigned char*)d_ws; p.ph_lo = 0; p.ph_hi = NPH;
    void* args[] = {&p};
    hipError_t e = hipLaunchCooperativeKernel((const void*)mk_fwd, dim3(grid), dim3(512), args, LDS_BYTES, stream);
    if (e != hipSuccess) fprintf(stderr, "cooperative launch failed: %s (grid %d)\n", hipGetErrorString(e), grid);
}
```

```cpp
#include <hip/hip_runtime.h>
#include <hip/hip_cooperative_groups.h>
#include <cstdio>
#include <cstdint>
namespace cg = cooperative_groups;

#define LAS __attribute__((address_space(3)))
typedef unsigned short bf16_t;
typedef short bf16x8 __attribute__((ext_vector_type(8)));
typedef float f32x4 __attribute__((ext_vector_type(4)));
typedef float f32x2 __attribute__((ext_vector_type(2)));
typedef unsigned u32x4 __attribute__((ext_vector_type(4)));
typedef unsigned u32x2 __attribute__((ext_vector_type(2)));

constexpr int T_ = 65536, D_ = 1024, SQ = 2048;
constexpr int INC = 4352, SHC = 1792, FF = 2816, FF2 = 5632, MODC = 6144;
constexpr int LDS_BYTES = 147456;
constexpr int LDS_BARW = LDS_BYTES - 16;
constexpr int NPH = 14;
#ifndef PHM
#define PHM 0xFFFFFu
#endif
#ifndef DUP_PHASE
#define DUP_PHASE -1
#endif

constexpr size_t MiB = 1048576;
constexpr size_t WS_CTL = 0;
constexpr size_t WS_MOD = 16384;
constexpr size_t WS_WIN = 1 * MiB;
constexpr size_t WS_WLORA = WS_WIN + (size_t)INC * 1024 * 2;
constexpr size_t WS_WOR = WS_WLORA + (size_t)1536 * 256 * 2;
constexpr size_t WS_WGLU = WS_WOR + (size_t)1024 * 512 * 2;
constexpr size_t WS_WOUT = WS_WGLU + (size_t)2048 * 512 * 2;
constexpr size_t WS_WUP = WS_WOUT + (size_t)1024 * 1024 * 2;
constexpr size_t WS_WDN = WS_WUP + (size_t)FF2 * 1024 * 2;
constexpr size_t WS_WEND = WS_WDN + (size_t)1024 * FF * 2;
static_assert(WS_WEND <= 32 * MiB, "weights overflow");
constexpr size_t WS_HB = 32 * MiB;
constexpr size_t WS_X1 = 160 * MiB;
constexpr size_t WS_PR = WS_X1;
constexpr size_t WS_LIN = WS_X1 + (size_t)T_ * SHC * 2;
constexpr size_t WS_U5 = 416 * MiB;
constexpr size_t WS_E = 480 * MiB;
constexpr size_t WS_AA = 544 * MiB;
constexpr size_t WS_GG = 608 * MiB;
constexpr size_t WS_YR = 672 * MiB;
constexpr size_t WS_D1 = WS_X1;
constexpr size_t WS_ACT = 416 * MiB;
constexpr size_t WS_HALO = 768 * MiB;
constexpr size_t WS_END = 944 * MiB;

struct Params {
    const float* in[34];
    float* out;
    unsigned char* ws;
    int ph_lo, ph_hi;
};
typedef const __attribute__((address_space(4))) Params* KP;
#define LAUNDER_TID(t) asm volatile("" : "+v"(t))
#define LAUNDER_S(x) asm volatile("" : "+s"(x))

__device__ __forceinline__ unsigned pk2(float lo, float hi) { unsigned r; asm("v_cvt_pk_bf16_f32 %0, %1, %2" : "=v"(r) : "v"(lo), "v"(hi)); return r; }
__device__ __forceinline__ unsigned f2bf(float f) { return pk2(f, 0.f) & 0xFFFFu; }
__device__ __forceinline__ float bf2f(unsigned short b) { return __uint_as_float(((unsigned)b) << 16); }
__device__ __forceinline__ float bflo(unsigned w) { return __uint_as_float(w << 16); }
__device__ __forceinline__ float bfhi(unsigned w) { return __uint_as_float(w & 0xFFFF0000u); }
__device__ __forceinline__ float sigmoidf_(float x) { return __builtin_amdgcn_rcpf(1.0f + __expf(-x)); }
__device__ __forceinline__ float wave_sum(float v) {
    v += __int_as_float(__builtin_amdgcn_update_dpp(0, __float_as_int(v), 0xB1, 0xF, 0xF, false));
    v += __int_as_float(__builtin_amdgcn_update_dpp(0, __float_as_int(v), 0x4E, 0xF, 0xF, false));
    v += __int_as_float(__builtin_amdgcn_update_dpp(0, __float_as_int(v), 0x141, 0xF, 0xF, false));
    v += __int_as_float(__builtin_amdgcn_update_dpp(0, __float_as_int(v), 0x140, 0xF, 0xF, false));
    const int iv = __float_as_int(v);
    const float r0 = __int_as_float(__builtin_amdgcn_readlane(iv, 0)), r1 = __int_as_float(__builtin_amdgcn_readlane(iv, 16));
    const float r2 = __int_as_float(__builtin_amdgcn_readlane(iv, 32)), r3 = __int_as_float(__builtin_amdgcn_readlane(iv, 48));
    return (r0 + r1) + (r2 + r3);
}
#define LDS_FENCE() asm volatile("s_waitcnt lgkmcnt(0)" ::: "memory")


#define XB_TMO      128
#define XB_XCNT(j)  (256  + 64 * (j))
#define XB_XSUB(j)  (1280 + 64 * (j))
#define XB_XGEN(j)  (2304 + 64 * (j))
#define XB_TOP      3328
#define XB_TOPGEN   3392
#define XCD_BAR_WORDS 3456
#define XB_SPIN_CAP (1u << 18)
__device__ __forceinline__ unsigned xb_ld(unsigned* p)              { return __hip_atomic_load(p, __ATOMIC_RELAXED, __HIP_MEMORY_SCOPE_AGENT); }
__device__ __forceinline__ unsigned xb_add(unsigned* p, unsigned v) { return __hip_atomic_fetch_add(p, v, __ATOMIC_RELAXED, __HIP_MEMORY_SCOPE_AGENT); }
__device__ __forceinline__ unsigned xb_xcc_id() { return (unsigned)__builtin_amdgcn_s_getreg((3 << 11) | 20) & 0xFu; }
#define XB_SPIN(cond, bar) do { unsigned _sp = 0; while (cond) { __builtin_amdgcn_s_sleep(1); \
    if ((++_sp & 255u) == 0u) { if (xb_ld(&(bar)[XB_TMO])) break; if (_sp > XB_SPIN_CAP) { atomicAdd(&(bar)[XB_TMO], 1u); break; } } } } while (0)
struct XcdBarrier { unsigned* bar; unsigned x; volatile LAS unsigned* st; };
__device__ __forceinline__ XcdBarrier xcd_barrier_post(unsigned* bar, volatile LAS unsigned* st) {
    XcdBarrier b; b.bar = bar; b.x = xb_xcc_id(); b.st = st;
    if (threadIdx.x == 0) (void)xb_add(&bar[XB_XCNT(b.x)], 1u);
    return b;
}
__device__ __forceinline__ void xcd_barrier_complete(unsigned* bar, unsigned x, unsigned& nloc, unsigned& nx) {
    const unsigned G = gridDim.x * gridDim.y * gridDim.z;
    unsigned sum, cnt, mine, sp = 0u;
    for (;;) {
        sum = 0u; cnt = 0u; mine = 0u;
#pragma unroll
        for (unsigned j = 0; j < 16; ++j) { const unsigned c = xb_ld(&bar[XB_XCNT(j)]); sum += c; cnt += (c > 0u) ? 1u : 0u; mine = (j == x) ? c : mine; }
        if (sum == G) break;
        __builtin_amdgcn_s_sleep(1);
        if ((++sp & 255u) == 0u) { if (xb_ld(&bar[XB_TMO])) break; if (sp > XB_SPIN_CAP) { atomicAdd(&bar[XB_TMO], 1u); break; } }
    }
    nloc = mine > 0u ? mine : 1u; nx = cnt > 0u ? cnt : 1u;
}
__device__ __forceinline__ void xcd_barrier(const XcdBarrier& b) {
    asm volatile("s_waitcnt vmcnt(0)" ::: "memory");
    __syncthreads();
    if (threadIdx.x == 0) {
        unsigned* bar = b.bar;
        __builtin_amdgcn_s_waitcnt(0);
        unsigned nloc = b.st[0], nx = b.st[1];
        if (nloc == 0u) { xcd_barrier_complete(bar, b.x, nloc, nx); b.st[0] = nloc; b.st[1] = nx; }
        const unsigned old = xb_add(&bar[XB_XSUB(b.x)], 1u);
        const unsigned gen = old / nloc;
        if (old + 1u == (gen + 1u) * nloc) {
            __builtin_amdgcn_fence(__ATOMIC_RELEASE, "agent");
            asm volatile("s_waitcnt vmcnt(0)" ::: "memory");
            const unsigned og = xb_add(&bar[XB_TOP], 1u);
            const unsigned tg = og / nx;
            if (og + 1u == (tg + 1u) * nx) xb_add(&bar[XB_TOPGEN], 1u);
            else XB_SPIN(xb_ld(&bar[XB_TOPGEN]) == tg, bar);
            __builtin_amdgcn_fence(__ATOMIC_ACQUIRE, "agent");
            xb_add(&bar[XB_XGEN(b.x)], 1u);
            asm volatile("s_waitcnt vmcnt(0)" ::: "memory");
        } else {
            XB_SPIN(xb_ld(&bar[XB_XGEN(b.x)]) == gen, bar);
            __builtin_amdgcn_fence(__ATOMIC_ACQUIRE, "agent");
            asm volatile("s_waitcnt vmcnt(0)" ::: "memory");
        }
    }
    __syncthreads();
}

namespace pg8 {
constexpr int BM = 256, BK = 64, HALF = 128, HTB = HALF * BK * 2, STAGE_BYTES = 8 * HTB, NXCD = 8, WGM = 8;
__host__ __device__ __forceinline__ int lds_byte(int r, int c) { const int st = (r >> 4) * 2 + (c >> 5), rr = r & 15, cc = c & 31, ob = rr * 64 + cc * 2; return st * 1024 + (ob ^ (((ob >> 9) & 1) << 5)); }
__host__ __device__ __forceinline__ void stage_rc(int b, int& R, int& C) { const int st = b / 1024, sb = b % 1024, swz = sb ^ (((sb >> 9) & 1) << 5); R = (st >> 1) * 16 + swz / 64; C = (st & 1) * 32 + (swz % 64) / 2; }
__host__ __device__ __forceinline__ int perm32(int rho) { const int n = rho >> 4, i = rho & 15; return 8 * (i >> 2) + 4 * n + (i & 3); }

struct Unit { int pm, pn; };
struct Gemm { const bf16_t* A; const bf16_t* Bt; int M, N, K; int permA; };

struct StaticOrder {
    int nM, nN, nwg, G, c;
    __device__ void init(int M, int N, int G_, int c_) { nM = M / BM; nN = N / BM; nwg = nM * nN; G = G_; c = c_; }
    __device__ bool next(int i, Unit& u) const {
        const long L = (long)i * G + c; if (L >= nwg) return false;
        int wgid = (int)L; { const int q = nwg / NXCD, r = nwg % NXCD, xcd = wgid % NXCD, off = wgid / NXCD; wgid = (xcd < r ? xcd * (q + 1) : r * (q + 1) + (xcd - r) * q) + off; }
        const int nig = WGM * nN, gid = wgid / nig, fm = gid * WGM, gsz = (nM - fm) < WGM ? (nM - fm) : WGM;
        u.pm = fm + ((wgid % nig) % gsz); u.pn = (wgid % nig) / gsz; return true;
    }
};

enum { M_ROUTE = 0, M_GLU, M_MIXADD, M_SCALE, M_CONV };
struct Epi {
    int mode;
    int c1, c2, ld0, ld1, ld2, sig2;
    bf16_t *o0, *o1, *o2;
    const bf16_t* gates;
    const float* gatev;
    const float *cw, *cb;
    __device__ __forceinline__ void operator()(const f32x4 (&acc)[2][2][4][2], const Unit& u, int wr, int wc, int fr, int fq) const {
        const int row0 = u.pm * BM + wr * 64 + fr;
        if (mode == M_ROUTE) {
            const int colt = u.pn * BM; bf16_t* base; int ld, cb; bool sig = false;
            if (colt < c1) { base = o0; ld = ld0; cb = colt; }
            else if (colt < c2) { base = o1; ld = ld1; cb = colt - c1; }
            else { base = o2; ld = ld2; cb = colt - c2; sig = sig2 != 0; }
            const int col0 = cb + wc * 32 + 8 * fq;
#pragma unroll
            for (int ai = 0; ai < 2; ++ai)
#pragma unroll
                for (int m = 0; m < 4; ++m) { bf16_t* rowp = base + (size_t)(row0 + ai * HALF + m * 16) * ld + col0;
#pragma unroll
                    for (int bj = 0; bj < 2; ++bj) { f32x4 a = acc[ai][bj][m][0], b = acc[ai][bj][m][1];
                        if (sig) {
#pragma unroll
                            for (int i = 0; i < 4; ++i) { a[i] = sigmoidf_(a[i]); b[i] = sigmoidf_(b[i]); } }
                        u32x4 o; o.x = pk2(a[0], a[1]); o.y = pk2(a[2], a[3]); o.z = pk2(b[0], b[1]); o.w = pk2(b[2], b[3]);
                        __builtin_nontemporal_store(o, (u32x4*)(rowp + bj * HALF)); } }
        } else if (mode == M_GLU) {
            const int col0 = u.pn * HALF + wc * 32 + 8 * fq;
            u32x4 gwv[2][4];
#pragma unroll
            for (int ai = 0; ai < 2; ++ai)
#pragma unroll
                for (int m = 0; m < 4; ++m) gwv[ai][m] = *(const u32x4*)(gates + (size_t)(row0 + ai * HALF + m * 16) * 2048 + 1024 + col0);
            __builtin_amdgcn_sched_barrier(0);
#pragma unroll
            for (int ai = 0; ai < 2; ++ai)
#pragma unroll
                for (int m = 0; m < 4; ++m) { const size_t row = (size_t)(row0 + ai * HALF + m * 16);
                    const u32x4 gw = gwv[ai][m];
                    const f32x4 ga0 = acc[ai][0][m][0], ga1 = acc[ai][0][m][1], gb0 = acc[ai][1][m][0], gb1 = acc[ai][1][m][1];
                    float r[8];
                    r[0] = ga0[0] * sigmoidf_(gb0[0]) * bflo(gw.x); r[1] = ga0[1] * sigmoidf_(gb0[1]) * bfhi(gw.x);
                    r[2] = ga0[2] * sigmoidf_(gb0[2]) * bflo(gw.y); r[3] = ga0[3] * sigmoidf_(gb0[3]) * bfhi(gw.y);
                    r[4] = ga1[0] * sigmoidf_(gb1[0]) * bflo(gw.z); r[5] = ga1[1] * sigmoidf_(gb1[1]) * bfhi(gw.z);
                    r[6] = ga1[2] * sigmoidf_(gb1[2]) * bflo(gw.w); r[7] = ga1[3] * sigmoidf_(gb1[3]) * bfhi(gw.w);
                    u32x4 o; o.x = pk2(r[0], r[1]); o.y = pk2(r[2], r[3]); o.z = pk2(r[4], r[5]); o.w = pk2(r[6], r[7]);
                    *(u32x4*)(o0 + row * 1024 + col0) = o; }
        } else if (mode == M_MIXADD) {
            const int col0 = u.pn * BM + wc * 32 + 8 * fq;
#pragma unroll
            for (int ai = 0; ai < 2; ++ai) {
                u32x4 gwv[4][2], mov[4][2];
#pragma unroll
                for (int m = 0; m < 4; ++m)
#pragma unroll
                    for (int bj = 0; bj < 2; ++bj) { const size_t row = (size_t)(row0 + ai * HALF + m * 16); const int col = col0 + bj * HALF;
                        gwv[m][bj] = *(const u32x4*)(gates + row * 2048 + col); mov[m][bj] = *(const u32x4*)(o0 + row * 1024 + col); }
                __builtin_amdgcn_sched_barrier(0);
#pragma unroll
                for (int m = 0; m < 4; ++m)
#pragma unroll
                    for (int bj = 0; bj < 2; ++bj) { const size_t row = (size_t)(row0 + ai * HALF + m * 16); const int col = col0 + bj * HALF;
                        const u32x4 gw = gwv[m][bj], mo = mov[m][bj];
                        const f32x4 a = acc[ai][bj][m][0], b = acc[ai][bj][m][1];
                        u32x4 o;
                        o.x = pk2(bflo(mo.x) + bflo(gw.x) * a[0], bfhi(mo.x) + bfhi(gw.x) * a[1]);
                        o.y = pk2(bflo(mo.y) + bflo(gw.y) * a[2], bfhi(mo.y) + bfhi(gw.y) * a[3]);
                        o.z = pk2(bflo(mo.z) + bflo(gw.z) * b[0], bfhi(mo.z) + bfhi(gw.z) * b[1]);
                        o.w = pk2(bflo(mo.w) + bflo(gw.w) * b[2], bfhi(mo.w) + bfhi(gw.w) * b[3]);
                        *(u32x4*)(o0 + row * 1024 + col) = o; }
            }
        } else if (mode == M_CONV) {
            const int jc = wc * 32 + 8 * fq, oc0 = u.pn * HALF + jc;
            const int rbase = u.pm * BM + wr * 64 + 4 * fr;
#pragma unroll
            for (int n = 0; n < 2; ++n) {
                const int oc = oc0 + 4 * n;
                f32x4 sg[2][4];
#pragma unroll
                for (int bj = 0; bj < 2; ++bj) {
                    const int wo = bj * FF + oc;
                    const f32x4 w0 = *(const f32x4*)(cw + wo), w1 = *(const f32x4*)(cw + FF2 + wo), w2 = *(const f32x4*)(cw + 2 * FF2 + wo), bb = *(const f32x4*)(cb + wo);
#pragma unroll
                    for (int ai = 0; ai < 2; ++ai) {
                        const f32x4 c0 = acc[ai][bj][0][n], c1 = acc[ai][bj][1][n], c2 = acc[ai][bj][2][n], c3 = acc[ai][bj][3][n];
                        f32x4 p3, p2;
#pragma unroll
                        for (int i = 0; i < 4; ++i) {
                            p3[i] = __int_as_float(__builtin_amdgcn_update_dpp(0, __float_as_int(c3[i]), 0x111, 0xF, 0xF, true));
                            p2[i] = __int_as_float(__builtin_amdgcn_update_dpp(0, __float_as_int(c2[i]), 0x111, 0xF, 0xF, true));
                        }
                        f32x4 ov[4];
                        ov[0] = bb + w2 * c0 + w1 * p3 + w0 * p2; ov[1] = bb + w2 * c1 + w1 * c0 + w0 * p3; ov[2] = bb + w2 * c2 + w1 * c1 + w0 * c0; ov[3] = bb + w2 * c3 + w1 * c2 + w0 * c1;
                        if (fr == 0 || fr == 15) {
                            const int blk = u.pm * 4 + ai * 2 + wr;
                            const f32x4 h0 = fr == 0 ? c0 : c2, h1 = fr == 0 ? c1 : c3;
                            bf16_t* hp = o1 + ((size_t)blk * 4 + (fr == 0 ? 0 : 2)) * FF2 + u.pn * BM + bj * HALF + jc + 4 * n;
                            u32x2 a; a.x = pk2(h0[0], h0[1]); a.y = pk2(h0[2], h0[3]); *(u32x2*)hp = a;
                            u32x2 b; b.x = pk2(h1[0], h1[1]); b.y = pk2(h1[2], h1[3]); *(u32x2*)(hp + FF2) = b;
                        }
                        if (bj == 0) {
#pragma unroll
                            for (int m = 0; m < 4; ++m)
#pragma unroll
                                for (int i = 0; i < 4; ++i) sg[ai][m][i] = ov[m][i] * sigmoidf_(ov[m][i]);
                        } else {
#pragma unroll
                            for (int m = 0; m < 4; ++m) { const f32x4 r = sg[ai][m] * ov[m];
                                u32x2 o; o.x = pk2(r[0], r[1]); o.y = pk2(r[2], r[3]);
                                *(u32x2*)(o0 + (size_t)(rbase + ai * HALF + m) * FF + oc) = o; }
                        }
                    }
                }
            }
        } else {
            const int col0 = u.pn * BM + wc * 32 + 8 * fq;
            const int bidx = (u.pm * BM) >> 11;
            f32x4 gv[2][2];
#pragma unroll
            for (int bj = 0; bj < 2; ++bj)
#pragma unroll
                for (int n = 0; n < 2; ++n) gv[bj][n] = *(const f32x4*)(gatev + (size_t)bidx * MODC + col0 + bj * HALF + 4 * n);
#pragma unroll
            for (int ai = 0; ai < 2; ++ai)
#pragma unroll
                for (int m = 0; m < 4; ++m) { bf16_t* rowp = o0 + (size_t)(row0 + ai * HALF + m * 16) * 1024 + col0;
#pragma unroll
                    for (int bj = 0; bj < 2; ++bj) { const f32x4 a = acc[ai][bj][m][0] * gv[bj][0], b = acc[ai][bj][m][1] * gv[bj][1];
                        u32x4 o; o.x = pk2(a[0], a[1]); o.y = pk2(a[2], a[3]); o.z = pk2(b[0], b[1]); o.w = pk2(b[2], b[3]);
                        *(u32x4*)(rowp + bj * HALF) = o; } }
        }
    }
};

__device__ __forceinline__ void gemm_phase(LAS unsigned char* lds, const Gemm g, const StaticOrder& S, const Epi& E) {
    int tid = threadIdx.x; LAUNDER_TID(tid);
    const int wid = __builtin_amdgcn_readfirstlane(tid >> 6), lane = tid & 63, wr = wid >> 2, wc = wid & 3, fr = lane & 15, fq = lane >> 4;
    const int K = g.K, nt = K / BK;
    unsigned voffA[2], voffB[2];
#pragma unroll
    for (int i = 0; i < 2; ++i) { int R, C; stage_rc(tid * 16 + i * 8192, R, C); const int Rb = (R & ~31) + perm32(R & 31);
        const int Ra = g.permA ? ((R & ~63) + 4 * (R & 15) + ((R >> 4) & 3)) : R;
        voffA[i] = (unsigned)(Ra * K + C) * 2u; voffB[i] = (unsigned)(Rb * K + C) * 2u; }
    const size_t kstep = (size_t)(BK * 2);
    const size_t hstep = (size_t)HALF * K * 2;
    const size_t tstep = 2 * hstep;
    const unsigned ldsw = (unsigned)wid * 1024u;
    const int aoff = lds_byte(wr * 64 + fr, fq * 8), boff = lds_byte(wc * 32 + fr, fq * 8);
#define PG8_SA(b, h) (((b) * 2 + (h)) * HTB)
#define PG8_SB(b, h) ((4 + (b) * 2 + (h)) * HTB)
#define PG8_STAGE(bufoff, gbase, voff) do { _Pragma("unroll") for (int _i = 0; _i < 2; ++_i) \
        __builtin_amdgcn_global_load_lds((const unsigned*)((const char*)(gbase) + (voff)[_i]), (LAS unsigned*)(lds + (bufoff) + ldsw + _i * 8192), 16, 0, 0); } while (0)
#define PG8_LDA(dst, b, h) do { _Pragma("unroll") for (int m = 0; m < 4; ++m) _Pragma("unroll") for (int k = 0; k < 2; ++k) dst[m][k] = *(const LAS bf16x8*)(lds + PG8_SA(b, h) + aoff + m * 2048 + k * 1024); } while (0)
#define PG8_LDB(dst, b, h) do { _Pragma("unroll") for (int n = 0; n < 2; ++n) _Pragma("unroll") for (int k = 0; k < 2; ++k) dst[n][k] = *(const LAS bf16x8*)(lds + PG8_SB(b, h) + boff + n * 2048 + k * 1024); } while (0)
#define PG8_MMA(ai, bj, At, Bt) do { __builtin_amdgcn_s_setprio(1); _Pragma("unroll") for (int m = 0; m < 4; ++m) _Pragma("unroll") for (int n = 0; n < 2; ++n) _Pragma("unroll") for (int k = 0; k < 2; ++k) \
        acc[ai][bj][m][n] = __builtin_amdgcn_mfma_f32_16x16x32_bf16(Bt[n][k], At[m][k], acc[ai][bj][m][n], 0, 0, 0); __builtin_amdgcn_s_setprio(0); } while (0)
#define PG8_WAIT_V(n) asm volatile("s_waitcnt vmcnt(" #n ")" ::: "memory")
#define PG8_WAIT_L(n) asm volatile("s_waitcnt lgkmcnt(" #n ")" ::: "memory")
#define PG8_BAR __builtin_amdgcn_s_barrier()
#define PG8_SCHED __builtin_amdgcn_sched_barrier(0)
    Unit cur, nxt; int ui = 0;
    if (!S.next(0, cur)) return;
    f32x4 acc[2][2][4][2];
#pragma unroll
    for (int a = 0; a < 2; ++a)
#pragma unroll
        for (int b = 0; b < 2; ++b)
#pragma unroll
            for (int m = 0; m < 4; ++m)
#pragma unroll
                for (int n = 0; n < 2; ++n) acc[a][b][m][n] = (f32x4){0.f, 0.f, 0.f, 0.f};
    bf16x8 At[4][2], B0[2][2], B1[2][2];
    const char* cA = (const char*)g.A + (size_t)cur.pm * tstep; const char* cB = (const char*)g.Bt + (size_t)cur.pn * tstep;
    PG8_STAGE(PG8_SB(0, 0), cB, voffB); PG8_STAGE(PG8_SB(0, 1), cB + hstep, voffB); PG8_STAGE(PG8_SA(0, 0), cA, voffA); PG8_STAGE(PG8_SA(0, 1), cA + hstep, voffA);
    if (wr == 1) PG8_BAR;
    PG8_WAIT_V(2); PG8_BAR;
    PG8_STAGE(PG8_SB(1, 0), cB + kstep, voffB); PG8_STAGE(PG8_SA(1, 0), cA + kstep, voffA); PG8_STAGE(PG8_SB(1, 1), cB + hstep + kstep, voffB);
    PG8_WAIT_V(6); PG8_BAR;
    for (;;) {
        const bool has_next = S.next(ui + 1, nxt);
        const char* nA = has_next ? (const char*)g.A + (size_t)nxt.pm * tstep : cA; const char* nB = has_next ? (const char*)g.Bt + (size_t)nxt.pn * tstep : cB;
        for (int t = 0; t < nt; t += 2) {
            const bool last = (t == nt - 2);
            const char* a1 = cA + (size_t)(t + 1) * kstep;
            const char* a2 = last ? nA : cA + (size_t)(t + 2) * kstep; const char* b2 = last ? nB : cB + (size_t)(t + 2) * kstep;
            const char* a3 = a2 + kstep; const char* b3 = b2 + kstep;
            PG8_LDB(B0, 0, 0); PG8_LDB(B1, 0, 1); PG8_SCHED; PG8_LDA(At, 0, 0); PG8_STAGE(PG8_SA(1, 1), a1 + hstep, voffA);
            PG8_WAIT_V(8); PG8_WAIT_L(0); PG8_BAR; PG8_MMA(0, 0, At, B0); PG8_MMA(0, 1, At, B1); PG8_BAR; PG8_SCHED;
            PG8_LDA(At, 0, 1); PG8_STAGE(PG8_SB(0, 0), b2, voffB); PG8_STAGE(PG8_SB(0, 1), b2 + hstep, voffB); PG8_STAGE(PG8_SA(0, 0), a2, voffA);
            PG8_WAIT_V(8); PG8_WAIT_L(0); PG8_BAR; PG8_MMA(1, 0, At, B0); PG8_MMA(1, 1, At, B1); PG8_BAR; PG8_SCHED;
            PG8_LDB(B0, 1, 0); PG8_LDB(B1, 1, 1); PG8_SCHED; PG8_LDA(At, 1, 0); PG8_STAGE(PG8_SA(0, 1), a2 + hstep, voffA);
            PG8_WAIT_V(8); PG8_WAIT_L(0); PG8_BAR; PG8_MMA(0, 0, At, B0); PG8_MMA(0, 1, At, B1); PG8_BAR; PG8_SCHED;
            PG8_LDA(At, 1, 1); PG8_STAGE(PG8_SB(1, 0), b3, voffB); PG8_STAGE(PG8_SB(1, 1), b3 + hstep, voffB); PG8_STAGE(PG8_SA(1, 0), a3, voffA);
            PG8_WAIT_V(8); PG8_WAIT_L(0); PG8_BAR; PG8_MMA(1, 0, At, B0); PG8_MMA(1, 1, At, B1); PG8_BAR; PG8_SCHED;
        }
        if (wr == 0) PG8_BAR;
        E(acc, cur, wr, wc, fr, fq);
        if (!has_next) break;
#pragma unroll
        for (int a = 0; a < 2; ++a)
#pragma unroll
            for (int b = 0; b < 2; ++b)
#pragma unroll
                for (int m = 0; m < 4; ++m)
#pragma unroll
                    for (int n = 0; n < 2; ++n) acc[a][b][m][n] = (f32x4){0.f, 0.f, 0.f, 0.f};
        cur = nxt; cA = nA; cB = nB; ++ui;
        if (wr == 1) PG8_BAR;
    }
    PG8_WAIT_V(0);
    PG8_BAR;
#undef PG8_SA
#undef PG8_SB
#undef PG8_STAGE
#undef PG8_LDA
#undef PG8_LDB
#undef PG8_MMA
#undef PG8_WAIT_V
#undef PG8_WAIT_L
#undef PG8_BAR
#undef PG8_SCHED
}
}

__device__ __forceinline__ int rowmap(int map, int n) {
    if (map == 0) return n;
    const int half = map == 1 ? 1024 : FF;
    const int hi = n >= half ? 1 : 0, nn = n - hi * half;
    return 256 * (nn >> 7) + 128 * hi + (nn & 127);
}
__device__ __forceinline__ void transpose_item(const float* __restrict__ W, int K, int N, bf16_t* WT, int map, LAS float* scr, int item, int lane) {
    const int nblk = N / 32, kb = item / nblk, nb = item % nblk, k0 = 64 * kb, n0 = 32 * nb;
    float tv[32];
#pragma unroll
    for (int i = 0; i < 32; ++i) { const int kk = 2 * i + (lane >> 5); tv[i] = W[(size_t)(k0 + kk) * N + n0 + (lane & 31)]; }
    __builtin_amdgcn_sched_barrier(0);
#pragma unroll
    for (int i = 0; i < 32; ++i) { const int kk = 2 * i + (lane >> 5); scr[kk * 33 + (lane & 31)] = tv[i]; }
    LDS_FENCE();
    const int c = lane & 7;
#pragma unroll
    for (int j = 0; j < 4; ++j) { const int n = (lane >> 3) + 8 * j; const LAS float* s = scr + (8 * c) * 33 + n;
        u32x4 o; o.x = pk2(s[0 * 33], s[1 * 33]); o.y = pk2(s[2 * 33], s[3 * 33]); o.z = pk2(s[4 * 33], s[5 * 33]); o.w = pk2(s[6 * 33], s[7 * 33]);
        *(u32x4*)(WT + (size_t)rowmap(map, n0 + n) * K + k0 + 8 * c) = o; }
    LDS_FENCE();
}

__device__ __forceinline__ void phase0(KP P, LAS unsigned char* lds) {
    int tid = threadIdx.x; LAUNDER_TID(tid); int bid = blockIdx.x; LAUNDER_S(bid);
    const int lane = tid & 63, wave = tid >> 6;
    const int gw = bid * 8 + wave, NGW = gridDim.x * 8;
    unsigned char* ws = P->ws;
    LAS float* sc = (LAS float*)lds;
    const float* c = P->in[1];
    for (int i = tid; i < 32 * 1024; i += 512) { const float v = c[i]; sc[i] = v * sigmoidf_(v); }
    __syncthreads();
    {
        const float* w_ada = P->in[2]; const float* b_ada = P->in[3]; float* mod = (float*)(ws + WS_MOD);
        for (int col = gw; col < MODC; col += NGW) {
            float w[16];
#pragma unroll
            for (int i = 0; i < 16; ++i) w[i] = w_ada[(size_t)(lane + 64 * i) * MODC + col];
            float keep = 0.f;
            for (int b = 0; b < 32; ++b) {
                float s = 0.f;
#pragma unroll
                for (int i = 0; i < 16; ++i) s += sc[b * 1024 + lane + 64 * i] * w[i];
                s = wave_sum(s);
                keep = (lane == b) ? s : keep;
            }
            if (lane < 32) mod[(size_t)lane * MODC + col] = keep + b_ada[col];
        }
    }
    __syncthreads();
    {
        LAS float* scr = (LAS float*)(lds + wave * 8448);
        constexpr int I_IN = (1024 / 64) * (INC / 32), I_OR = (512 / 64) * (1024 / 32), I_GLU = (512 / 64) * (2048 / 32), I_OUT = (1024 / 64) * (1024 / 32),
                      I_UP = (1024 / 64) * (FF2 / 32), I_DN = (FF / 64) * (1024 / 32);
        constexpr int NITEMS = I_IN + I_OR + I_GLU + I_OUT + I_UP + I_DN;
        for (int it = gw; it < NITEMS; it += NGW) {
            int r = it;
            if (r < I_IN) { transpose_item(P->in[5], 1024, INC, (bf16_t*)(ws + WS_WIN), 0, scr, r, lane); continue; } r -= I_IN;
            if (r < I_OR) { transpose_item(P->in[17], 512, 1024, (bf16_t*)(ws + WS_WOR), 0, scr, r, lane); continue; } r -= I_OR;
            if (r < I_GLU) { transpose_item(P->in[26], 512, 2048, (bf16_t*)(ws + WS_WGLU), 1, scr, r, lane); continue; } r -= I_GLU;
            if (r < I_OUT) { transpose_item(P->in[27], 1024, 1024, (bf16_t*)(ws + WS_WOUT), 0, scr, r, lane); continue; } r -= I_OUT;
            if (r < I_UP) { transpose_item(P->in[29], 1024, FF2, (bf16_t*)(ws + WS_WUP), 2, scr, r, lane); continue; } r -= I_UP;
            transpose_item(P->in[32], FF, 1024, (bf16_t*)(ws + WS_WDN), 0, scr, r, lane);
        }
    }
    {
        bf16_t* wl = (bf16_t*)(ws + WS_WLORA);
        const float* w_up = P->in[8]; const float* a_up = P->in[10]; const float* g_up = P->in[11];
        for (int idx = bid * 512 + tid; idx < 1536 * 256; idx += gridDim.x * 512) {
            const int n = idx >> 8, k = idx & 255, which = n >> 9, nn = n & 511;
            float v = 0.f;
            if (which == 0) { if (k < 64) v = w_up[k * 512 + nn]; }
            else if (which == 1) { if (k >= 64 && k < 128) v = a_up[(k - 64) * 512 + nn]; }
            else { if (k >= 128) v = g_up[(k - 128) * 512 + nn]; }
            wl[idx] = (bf16_t)f2bf(v);
        }
    }
}

template <int MODE>
__device__ __forceinline__ void phase_norm(const float* X, const bf16_t* dl, const bf16_t* dl2, const float* g, const float* mod, int sh_off, int sc_off, bf16_t* outb, float* outf) {
    int tid = threadIdx.x; LAUNDER_TID(tid); int bid = blockIdx.x; LAUNDER_S(bid);
    const int lane = tid & 63, wave = tid >> 6;
    const int gw = bid * 8 + wave, NGW = gridDim.x * 8;
    f32x4 gg[4];
#pragma unroll
    for (int j = 0; j < 4; ++j) gg[j] = *(const f32x4*)(g + lane * 4 + 256 * j);
    for (int rp = gw; rp < T_ / 2; rp += NGW) {
        f32x4 v[2][4]; u32x2 dw[2][4], dw2[2][4];
#pragma unroll
        for (int r = 0; r < 2; ++r) {
            const size_t row = (size_t)(2 * rp + r);
            const f32x4* xr = (const f32x4*)(X + row * 1024) + lane;
#pragma unroll
            for (int j = 0; j < 4; ++j) v[r][j] = xr[64 * j];
            if (MODE != 0) {
#pragma unroll
                for (int j = 0; j < 4; ++j) dw[r][j] = *(const u32x2*)(dl + row * 1024 + lane * 4 + 256 * j);
            }
            if (MODE == 1) {
#pragma unroll
                for (int j = 0; j < 4; ++j) dw2[r][j] = *(const u32x2*)(dl2 + row * 1024 + lane * 4 + 256 * j);
            }
        }
#pragma unroll
        for (int r = 0; r < 2; ++r) {
            const size_t row = (size_t)(2 * rp + r);
            float ss = 0.f;
#pragma unroll
            for (int j = 0; j < 4; ++j) {
                if (MODE != 0) { v[r][j].x += bflo(dw[r][j].x); v[r][j].y += bfhi(dw[r][j].x); v[r][j].z += bflo(dw[r][j].y); v[r][j].w += bfhi(dw[r][j].y); }
                if (MODE == 1) { v[r][j].x += bflo(dw2[r][j].x); v[r][j].y += bfhi(dw2[r][j].x); v[r][j].z += bflo(dw2[r][j].y); v[r][j].w += bfhi(dw2[r][j].y); }
                ss += (v[r][j].x * v[r][j].x + v[r][j].y * v[r][j].y) + (v[r][j].z * v[r][j].z + v[r][j].w * v[r][j].w);
            }
            ss = wave_sum(ss);
            const float inv = rsqrtf(ss * (1.0f / 1024.0f) + 1e-6f);
            if (MODE != 1) {
                const int b = (int)(row >> 11);
#pragma unroll
                for (int j = 0; j < 4; ++j) { const int col = lane * 4 + 256 * j;
                    const f32x4 sc = *(const f32x4*)(mod + (size_t)b * MODC + sc_off + col), sh = *(const f32x4*)(mod + (size_t)b * MODC + sh_off + col);
                    const f32x4 o = v[r][j] * inv * gg[j] * (sc + 1.0f) + sh;
                    u32x2 w; w.x = pk2(o.x, o.y); w.y = pk2(o.z, o.w);
                    *(u32x2*)(outb + row * 1024 + col) = w;
                    }
            } else {
#pragma unroll
                for (int j = 0; j < 4; ++j) { const int col = lane * 4 + 256 * j;
                    *(f32x4*)(outf + row * 1024 + col) = v[r][j] * inv * gg[j]; }
            }
        }
    }
}

__device__ __forceinline__ float gelu_tanh(float x) {
    const float u = 0.7978845608f * (x + 0.044715f * x * x * x);
    const float e = __expf(2.0f * u);
    const float t = 1.0f - 2.0f * __builtin_amdgcn_rcpf(1.0f + e);
    return 0.5f * x * (1.0f + t);
}
__device__ __forceinline__ void s5_q(const float* a_re, const float* a_im, float dt, int idx, float& qre, float& qim) {
    const float are = a_re[idx], aim = a_im[idx];
    const float zre = are * dt, zim = aim * dt, mag = expf(zre);
    const float abre = mag * cosf(zim), abim = mag * sinf(zim);
    const float den = are * are + aim * aim;
    qre = ((abre - 1.0f) * are + abim * aim) / den;
    qim = (abim * are - (abre - 1.0f) * aim) / den;
}
struct S5Regs { bf16x8 af; float ar, ai, dval, xr, xi; size_t ubase; };
__device__ __forceinline__ void s5_setup(KP P, int b, int g, int lane, S5Regs& R, LAS bf16_t* BB) {
    const bf16_t* U = (const bf16_t*)(P->ws + WS_U5);
    const int l15 = lane & 15, quad = lane >> 4;
    const float dt = expf(P->in[20][g]);
    { const float are = P->in[18][g * 64 + lane], aim = P->in[19][g * 64 + lane]; const float mag = expf(are * dt); R.ar = mag * cosf(aim * dt); R.ai = mag * sinf(aim * dt); }
#pragma unroll
    for (int pt = 0; pt < 4; ++pt) {
        const int pp = pt * 16 + l15;
        float qre, qim; s5_q(P->in[18], P->in[19], dt, g * 64 + pp, qre, qim);
        bf16x8 fre, fim;
#pragma unroll
        for (int j = 0; j < 8; ++j) {
            float vre = 0.f, vim = 0.f;
            if (quad < 2) { const int cidx = (g * 64 + pp) * 16 + quad * 8 + j; const float bre = P->in[21][cidx], bim = P->in[22][cidx];
                vre = qre * bre - qim * bim; vim = qre * bim + qim * bre; }
            fre[j] = (short)f2bf(vre); fim[j] = (short)f2bf(vim);
        }
        if (quad < 2) { *(LAS bf16x8*)(BB + (pp) * 16 + quad * 8) = fre; *(LAS bf16x8*)(BB + (64 + pp) * 16 + quad * 8) = fim; }
    }
#pragma unroll
    for (int kk = 0; kk < 4; ++kk) {
        bf16x8 f;
#pragma unroll
        for (int j = 0; j < 8; ++j) { const int k = kk * 32 + quad * 8 + j;
            const float v = k < 64 ? P->in[23][(g * 16 + l15) * 64 + k] : -P->in[24][(g * 16 + l15) * 64 + (k - 64)];
            f[j] = (short)f2bf(v); }
        *(LAS bf16x8*)(BB + 128 * 16 + l15 * 128 + kk * 32 + quad * 8) = f;
    }
    R.dval = P->in[25][g * 16 + l15];
    R.xr = 0.f; R.xi = 0.f;
    R.ubase = (size_t)b * SQ * 512 + g * 16;
    R.af = (bf16x8){0, 0, 0, 0, 0, 0, 0, 0};
    if (quad < 2) R.af = *(const bf16x8*)(U + R.ubase + (size_t)l15 * 512 + quad * 8);
}
__device__ __forceinline__ void s5_chunk(KP P, S5Regs& R, int ck, LAS float* BU, LAS bf16_t* XB, const LAS bf16_t* BB, int lane) {
    bf16_t* U = (bf16_t*)(P->ws + WS_U5);
    const int l15 = lane & 15, quad = lane >> 4;
    const int t0 = ck * 16;
    bf16x8 afn = (bf16x8){0, 0, 0, 0, 0, 0, 0, 0};
    if (quad < 2 && ck + 1 < SQ / 16) afn = *(const bf16x8*)(U + R.ubase + (size_t)(t0 + 16 + l15) * 512 + quad * 8);
    float uo[4];
#pragma unroll
    for (int j = 0; j < 4; ++j) uo[j] = bf2f(U[R.ubase + (size_t)(t0 + quad * 4 + j) * 512 + l15]);
#pragma unroll
    for (int q = 0; q < 8; ++q) {
        const bf16x8 bq = *(const LAS bf16x8*)(BB + (q * 16 + l15) * 16 + (quad & 1) * 8);
        f32x4 d = __builtin_amdgcn_mfma_f32_16x16x32_bf16(R.af, bq, (f32x4){0.f, 0.f, 0.f, 0.f}, 0, 0, 0);
#pragma unroll
        for (int j = 0; j < 4; ++j) BU[(quad * 4 + j) * 128 + q * 16 + l15] = d[j];
    }
    LDS_FENCE();
    float xr = R.xr, xi = R.xi;
#pragma unroll
    for (int tt = 0; tt < 16; ++tt) {
        const float bre = BU[tt * 128 + lane], bim = BU[tt * 128 + 64 + lane];
        const float nr = R.ar * xr - R.ai * xi + bre, ni = R.ar * xi + R.ai * xr + bim;
        xr = nr; xi = ni;
        XB[tt * 136 + lane] = (bf16_t)f2bf(xr); XB[tt * 136 + 64 + lane] = (bf16_t)f2bf(xi);
    }
    R.xr = xr; R.xi = xi;
    LDS_FENCE();
    f32x4 y = (f32x4){0.f, 0.f, 0.f, 0.f};
#pragma unroll
    for (int kk = 0; kk < 4; ++kk) {
        const bf16x8 a2 = *(const LAS bf16x8*)(XB + l15 * 136 + kk * 32 + quad * 8);
        const bf16x8 cmk = *(const LAS bf16x8*)(BB + 128 * 16 + l15 * 128 + kk * 32 + quad * 8);
        y = __builtin_amdgcn_mfma_f32_16x16x32_bf16(a2, cmk, y, 0, 0, 0);
    }
#pragma unroll
    for (int j = 0; j < 4; ++j) {
        const float yv = y[j] + R.dval * uo[j];
        U[R.ubase + (size_t)(t0 + quad * 4 + j) * 512 + l15] = (bf16_t)f2bf(gelu_tanh(yv));
    }
    LDS_FENCE();
    R.af = afn;
}
__device__ __forceinline__ void phase_lora_in(KP P) {
    int tid = threadIdx.x; LAUNDER_TID(tid); int bid = blockIdx.x; LAUNDER_S(bid);
    const int lane = tid & 63, wave = tid >> 6;
    unsigned char* ws = P->ws;
    const bf16_t* PR = (const bf16_t*)(ws + WS_PR); bf16_t* LIN = (bf16_t*)(ws + WS_LIN);
    const f32x4 mu = *(const f32x4*)(P->in[6] + 1536 + lane * 4);
    for (int row = bid * 8 + wave; row < T_; row += gridDim.x * 8) {
        const u32x2 cw = *(const u32x2*)(PR + (size_t)row * SHC + 1536 + lane * 4);
        u32x2 pw; pw.x = 0u; pw.y = 0u;
        if ((row & (SQ - 1)) != 0) pw = *(const u32x2*)(PR + (size_t)(row - 1) * SHC + 1536 + lane * 4);
        float cv[4] = {bflo(cw.x), bfhi(cw.x), bflo(cw.y), bfhi(cw.y)}, pv[4] = {bflo(pw.x), bfhi(pw.x), bflo(pw.y), bfhi(pw.y)};
        const float muv[4] = {mu.x, mu.y, mu.z, mu.w};
        float o[4];
#pragma unroll
        for (int i = 0; i < 4; ++i) {
            const float p = cv[i] + (pv[i] - cv[i]) * muv[i];
            const float th = 1.0f - 2.0f * __builtin_amdgcn_rcpf(1.0f + __expf(2.0f * p));
            const float sg = sigmoidf_(p);
            o[i] = lane < 16 ? th : (lane < 32 ? p : sg);
        }
        u32x2 w; w.x = pk2(o[0], o[1]); w.y = pk2(o[2], o[3]);
        *(u32x2*)(LIN + (size_t)row * 256 + lane * 4) = w;
    }
}

constexpr int RW_CH = 16;
constexpr int RW_OPS = 5 * RW_CH * 64 * 4;
constexpr int RW_VC = RW_CH * 64 * 4 + 256;
constexpr int RW_VCOFF = 2 * RW_OPS;
constexpr int RW_YOFF = RW_VCOFF + 3 * RW_VC;
constexpr int RW_S5OFF = RW_YOFF + 2 * RW_CH * 64 * 4;
constexpr int S5_WB = 8192 + 4352 + 4096 + 4096;
static_assert(RW_S5OFF + 4 * S5_WB <= LDS_BARW, "rwkv lds");

struct RwConst { float mur, muk, muv, kkw, kaw, rkw, w0c, a0c, lg, lb; };
struct RwPrepLd { float cr[4], ck[4], cv[4], pr[4], pk[4], pv[4], e[4], a[4]; };
__device__ __forceinline__ void rw_const(KP P, int h, int lane, RwConst& C) {
    const int ch = h * 64 + lane;
    C.mur = P->in[6][ch]; C.muk = P->in[6][512 + ch]; C.muv = P->in[6][1024 + ch];
    C.kkw = P->in[12][ch]; C.kaw = P->in[13][ch]; C.rkw = P->in[14][ch]; C.w0c = P->in[7][ch]; C.a0c = P->in[9][ch];
    C.lg = P->in[15][ch]; C.lb = P->in[16][ch];
}
__device__ __forceinline__ void rw_prep_load(KP P, int b, int h, int chunk, int wl, int lane, RwPrepLd& L) {
    const unsigned char* ws = P->ws;
    const bf16_t* PR = (const bf16_t*)(ws + WS_PR); const bf16_t* E = (const bf16_t*)(ws + WS_E); const bf16_t* AA = (const bf16_t*)(ws + WS_AA);
    const int ch = h * 64 + lane;
#pragma unroll
    for (int i = 0; i < RW_CH / 4; ++i) {
        const int tt = wl + 4 * i, s = chunk * RW_CH + tt; const size_t row = (size_t)b * SQ + s;
        L.cr[i] = bf2f(PR[row * SHC + ch]); L.ck[i] = bf2f(PR[row * SHC + 512 + ch]); L.cv[i] = bf2f(PR[row * SHC + 1024 + ch]);
        const size_t prow = s > 0 ? row - 1 : row;
        L.pr[i] = bf2f(PR[prow * SHC + ch]); L.pk[i] = bf2f(PR[prow * SHC + 512 + ch]); L.pv[i] = bf2f(PR[prow * SHC + 1024 + ch]);
        L.e[i] = bf2f(E[row * 512 + ch]); L.a[i] = bf2f(AA[row * 512 + ch]);
    }
}
__device__ __forceinline__ void rw_prep_compute(LAS unsigned char* opsp, LAS unsigned char* vcp, const RwConst& C, const RwPrepLd& L, int chunk, int wl, int lane) {
    LAS float* Wb = (LAS float*)opsp; LAS float* Ab = Wb + RW_CH * 64; LAS float* Bb = Ab + RW_CH * 64; LAS float* Kb = Bb + RW_CH * 64; LAS float* Rb = Kb + RW_CH * 64; LAS float* Vb = (LAS float*)vcp;
    LAS float* Cf = Vb + RW_CH * 64;
#pragma unroll
    for (int i = 0; i < RW_CH / 4; ++i) {
        const int tt = wl + 4 * i, s = chunk * RW_CH + tt;
        const float pr = s > 0 ? L.pr[i] : 0.f, pk = s > 0 ? L.pk[i] : 0.f, pv = s > 0 ? L.pv[i] : 0.f;
        const float r = L.cr[i] + (pr - L.cr[i]) * C.mur, k = L.ck[i] + (pk - L.ck[i]) * C.muk, v = L.cv[i] + (pv - L.cv[i]) * C.muv;
        const float w = exp2f(-0.87504106f * sigmoidf_(C.w0c + L.e[i]));
        const float a = sigmoidf_(C.a0c + L.a[i]);
        float kk = k * C.kkw;
        const float ss = wave_sum(kk * kk);
        kk *= rsqrtf(ss + 1e-12f);
        const float kmod = k * (1.0f + (a - 1.0f) * C.kaw);
        const float coef = wave_sum(r * kmod * C.rkw);
        Wb[tt * 64 + lane] = w; Ab[tt * 64 + lane] = -kk; Bb[tt * 64 + lane] = kk * a; Kb[tt * 64 + lane] = kmod; Rb[tt * 64 + lane] = r; Vb[tt * 64 + lane] = v;
        if (lane == 0) Cf[tt] = coef;
    }
}
__device__ __forceinline__ void rw_post_load(KP P, int b, int h, int chunk, int wl, int lane, float (&g)[4]) {
    const bf16_t* GG = (const bf16_t*)(P->ws + WS_GG);
    const int ch = h * 64 + lane;
#pragma unroll
    for (int i = 0; i < 4; ++i) { const size_t row = (size_t)b * SQ + chunk * RW_CH + wl + 4 * i; g[i] = bf2f(GG[row * 512 + ch]); }
}
__device__ __forceinline__ void rw_post_compute(KP P, LAS unsigned char* vcp, LAS float* yb, const RwConst& C, const float (&g)[4], int b, int h, int chunk, int wl, int lane) {
    bf16_t* YR = (bf16_t*)(P->ws + WS_YR);
    const int ch = h * 64 + lane;
    LAS float* Vb = (LAS float*)vcp; LAS float* Cf = Vb + RW_CH * 64;
#pragma unroll
    for (int i = 0; i < 4; ++i) {
        const int tt = wl + 4 * i;
        const size_t row = (size_t)b * SQ + chunk * RW_CH + tt;
        const float y = yb[tt * 64 + lane];
        const float mean = wave_sum(y) * (1.0f / 64.0f);
        const float d = y - mean;
        const float var = wave_sum(d * d) * (1.0f / 64.0f);
        const float yn = d * rsqrtf(var + 64e-5f) * C.lg + C.lb;
        YR[row * 512 + ch] = (bf16_t)f2bf((yn + Cf[tt] * Vb[tt * 64 + lane]) * g[i]);
    }
}
__device__ __forceinline__ float dpp_xor1(float v) { return __int_as_float(__builtin_amdgcn_update_dpp(0, __float_as_int(v), 0xB1, 0xF, 0xF, false)); }
__device__ __forceinline__ float dpp_hmirror(float v) { return __int_as_float(__builtin_amdgcn_update_dpp(0, __float_as_int(v), 0x141, 0xF, 0xF, false)); }
__device__ __forceinline__ float dpp_xor2(float v) { return __int_as_float(__builtin_amdgcn_update_dpp(0, __float_as_int(v), 0x4E, 0xF, 0xF, false)); }
__device__ __forceinline__ void phase_rwkv(KP P, LAS unsigned char* lds, bool do_s5) {
    int tid = threadIdx.x; LAUNDER_TID(tid); int bid = blockIdx.x; LAUNDER_S(bid);
    const int lane = tid & 63, wave = __builtin_amdgcn_readfirstlane(tid >> 6);
    constexpr int NCH = SQ / RW_CH;
    for (int bh = bid; bh < 256; bh += gridDim.x) {
        const int b = bh >> 3, h = bh & 7;
        f32x4 S0[2], S1[2];
#pragma unroll
        for (int k = 0; k < 2; ++k) { S0[k] = (f32x4){0.f, 0.f, 0.f, 0.f}; S1[k] = (f32x4){0.f, 0.f, 0.f, 0.f}; }
        const bool helper = wave >= 4;
        const int hj = wave & 3;
        S5Regs R5;
        LAS float* BU5 = (LAS float*)(lds + RW_S5OFF + hj * S5_WB); LAS bf16_t* XB5 = (LAS bf16_t*)(lds + RW_S5OFF + hj * S5_WB + 8192); LAS bf16_t* BB5 = (LAS bf16_t*)(lds + RW_S5OFF + hj * S5_WB + 8192 + 4352);
        RwConst RC; RwPrepLd RL; float gq[4] = {0.f, 0.f, 0.f, 0.f};
        if (helper) { const int chain = bh * 4 + hj; s5_setup(P, chain >> 5, chain & 31, lane, R5, BB5); rw_const(P, h, lane, RC); rw_prep_load(P, b, h, 0, hj, lane, RL); rw_prep_compute(lds, lds + RW_VCOFF, RC, RL, 0, hj, lane); }
        __syncthreads();
        for (int c = 0; c < NCH; ++c) {
            if (!helper) {
                const int ko = lane & 7, rowv = 16 * wave + 2 * (lane >> 3);
                LAS unsigned char* bufp = lds + (c & 1) * RW_OPS;
                const LAS f32x4* W4 = (const LAS f32x4*)bufp + ko * 2; const LAS f32x4* A4 = W4 + RW_CH * 16; const LAS f32x4* B4 = A4 + RW_CH * 16; const LAS f32x4* K4 = B4 + RW_CH * 16; const LAS f32x4* R4 = K4 + RW_CH * 16;
                const LAS f32x2* Vb2 = (const LAS f32x2*)((const LAS float*)(lds + RW_VCOFF + (c % 3) * RW_VC) + rowv);
                LAS f32x2* yb2 = (LAS f32x2*)((LAS float*)(lds + RW_YOFF) + (c & 1) * RW_CH * 64 + rowv);
                f32x4 a[2][2]; f32x2 vv[2];
                f32x4 ew[2][2], eb[2][2], ek[2][2], er[2][2];
                auto issue = [&](int t, int g) {
                    const int p = t & 1, ta = t & (RW_CH - 1);
                    if (g == 0) {
                        a[p][0] = A4[ta * 16]; a[p][1] = A4[ta * 16 + 1];
                        vv[p] = Vb2[ta * 32];
                    } else {
                        const int e = g - 1, o = ta * 16 + e;
                        ew[p][e] = W4[o]; eb[p][e] = B4[o]; ek[p][e] = K4[o]; er[p][e] = R4[o];
                    }
                };
                issue(0, 0); issue(0, 1); issue(0, 2);
#pragma unroll
                for (int tt = 0; tt < RW_CH; ++tt) {
                    const int p = tt & 1;
                    __builtin_amdgcn_sched_barrier(0); issue(tt + 1, 0); __builtin_amdgcn_sched_barrier(0);
                    const float v0 = vv[p].x, v1 = vv[p].y;
                    const f32x4 q0 = S0[0] * a[p][0] + S0[1] * a[p][1], q1 = S1[0] * a[p][0] + S1[1] * a[p][1];
                    float sa0 = (q0.x + q0.y) + (q0.z + q0.w), sa1 = (q1.x + q1.y) + (q1.z + q1.w);
                    sa0 += dpp_xor1(sa0); sa1 += dpp_xor1(sa1); sa0 += dpp_xor2(sa0); sa1 += dpp_xor2(sa1); sa0 += dpp_hmirror(sa0); sa1 += dpp_hmirror(sa1);
                    f32x4 y0 = (f32x4){0.f, 0.f, 0.f, 0.f}, y1 = (f32x4){0.f, 0.f, 0.f, 0.f};
#pragma unroll
                    for (int e = 0; e < 2; ++e) {
                        __builtin_amdgcn_sched_barrier(0); issue(tt + 1, 1 + e); __builtin_amdgcn_sched_barrier(0);
                        S0[e] = S0[e] * ew[p][e] + (eb[p][e] * sa0 + ek[p][e] * v0); y0 += S0[e] * er[p][e];
                        S1[e] = S1[e] * ew[p][e] + (eb[p][e] * sa1 + ek[p][e] * v1); y1 += S1[e] * er[p][e];
                    }
                    __builtin_amdgcn_sched_barrier(0);
                    float r0 = (y0.x + y0.y) + (y0.z + y0.w), r1 = (y1.x + y1.y) + (y1.z + y1.w);
                    r0 += dpp_xor1(r0); r1 += dpp_xor1(r1); r0 += dpp_xor2(r0); r1 += dpp_xor2(r1); r0 += dpp_hmirror(r0); r1 += dpp_hmirror(r1);
                    yb2[tt * 32] = (f32x2){r0, r1};
                }
            } else {
                if (c + 1 < NCH) rw_prep_load(P, b, h, c + 1, hj, lane, RL);
                if (c >= 1) rw_post_load(P, b, h, c - 1, hj, lane, gq);
                if (do_s5) s5_chunk(P, R5, c, BU5, XB5, BB5, lane);
                if (c + 1 < NCH) rw_prep_compute(lds + ((c + 1) & 1) * RW_OPS, lds + RW_VCOFF + ((c + 1) % 3) * RW_VC, RC, RL, c + 1, hj, lane);
                if (c >= 1) rw_post_compute(P, lds + RW_VCOFF + ((c - 1) % 3) * RW_VC, (LAS float*)(lds + RW_YOFF) + ((c - 1) & 1) * RW_CH * 64, RC, gq, b, h, c - 1, hj, lane);
            }
            __syncthreads();
        }
        if (helper) { rw_post_load(P, b, h, NCH - 1, hj, lane, gq); rw_post_compute(P, lds + RW_VCOFF + ((NCH - 1) % 3) * RW_VC, (LAS float*)(lds + RW_YOFF) + ((NCH - 1) & 1) * RW_CH * 64, RC, gq, b, h, NCH - 1, hj, lane); }
        __syncthreads();
    }
}

__device__ __forceinline__ void phase_fixup(KP P) {
    const bf16_t* HALO = (const bf16_t*)(P->ws + WS_HALO); bf16_t* ACT = (bf16_t*)(P->ws + WS_ACT);
    const float* cw = P->in[30]; const float* cb = P->in[31];
    constexpr int NCG = FF / 8, NITEM = (T_ / 64) * NCG;
    int tid = threadIdx.x; LAUNDER_TID(tid); int bid = blockIdx.x; LAUNDER_S(bid);
    for (int it = bid * 512 + tid; it < NITEM; it += gridDim.x * 512) {
        const int cg8 = it % NCG, blk = it / NCG;
        const int oc = cg8 * 8, pn = oc >> 7, j0 = oc & 127;
        const int hg = 256 * pn + j0, hu = hg + 128;
        const bool first = ((blk * 64) & (SQ - 1)) == 0;
        float g[4][8], uu[4][8];
#pragma unroll
        for (int r = 0; r < 4; ++r) {
            const bool z = first && r < 2;
            const size_t hrow = r < 2 ? ((size_t)(z ? blk : blk - 1) * 4 + 2 + r) : ((size_t)blk * 4 + (r - 2));
            const u32x4 a = *(const u32x4*)(HALO + hrow * FF2 + hg), b = *(const u32x4*)(HALO + hrow * FF2 + hu);
            g[r][0] = bflo(a.x); g[r][1] = bfhi(a.x); g[r][2] = bflo(a.y); g[r][3] = bfhi(a.y); g[r][4] = bflo(a.z); g[r][5] = bfhi(a.z); g[r][6] = bflo(a.w); g[r][7] = bfhi(a.w);
            uu[r][0] = bflo(b.x); uu[r][1] = bfhi(b.x); uu[r][2] = bflo(b.y); uu[r][3] = bfhi(b.y); uu[r][4] = bflo(b.z); uu[r][5] = bfhi(b.z); uu[r][6] = bflo(b.w); uu[r][7] = bfhi(b.w);
            if (z) {
#pragma unroll
                for (int i = 0; i < 8; ++i) { g[r][i] = 0.f; uu[r][i] = 0.f; }
            }
        }
#pragma unroll
        for (int rr = 0; rr < 2; ++rr) {
            float o[8];
#pragma unroll
            for (int i = 0; i < 8; ++i) {
                const float gv = cb[oc + i] + cw[oc + i] * g[rr][i] + cw[FF2 + oc + i] * g[rr + 1][i] + cw[2 * FF2 + oc + i] * g[rr + 2][i];
                const float uv = cb[FF + oc + i] + cw[FF + oc + i] * uu[rr][i] + cw[FF2 + FF + oc + i] * uu[rr + 1][i] + cw[2 * FF2 + FF + oc + i] * uu[rr + 2][i];
                o[i] = gv * sigmoidf_(gv) * uv;
            }
            u32x4 ow; ow.x = pk2(o[0], o[1]); ow.y = pk2(o[2], o[3]); ow.z = pk2(o[4], o[5]); ow.w = pk2(o[6], o[7]);
            *(u32x4*)(ACT + ((size_t)blk * 64 + rr) * FF + oc) = ow;
        }
    }
}

__global__ void __launch_bounds__(512, 2) mk_fwd(Params Pv) {
    extern __shared__ __attribute__((aligned(16))) unsigned char shm[];
    LAS unsigned char* lds = (LAS unsigned char*)shm;
    cg::grid_group grid = cg::this_grid();
    const int ph_lo = Pv.ph_lo, ph_hi = Pv.ph_hi;
    volatile LAS unsigned* bst = (volatile LAS unsigned*)(lds + LDS_BARW);
    if (threadIdx.x == 0) { bst[0] = 0u; bst[1] = 0u; }
    __syncthreads();
    const XcdBarrier xbar = xcd_barrier_post((unsigned*)(Pv.ws + WS_CTL), bst);
    for (int phx = ph_lo; phx < ph_hi + (DUP_PHASE >= 0 ? 1 : 0); ++phx) {
        const int ph = (DUP_PHASE >= 0 && phx > DUP_PHASE) ? phx - 1 : phx;
        const bool rep = (DUP_PHASE >= 0 && phx == DUP_PHASE + 1);
        if (phx == ph_lo + 1) grid.sync();
        else if (phx > ph_lo) xcd_barrier(xbar);
        KP P = (KP)__builtin_amdgcn_kernarg_segment_ptr(); LAUNDER_S(P);
        unsigned char* ws = P->ws;
        float* mod = (float*)(ws + WS_MOD);
        pg8::Gemm g; pg8::Epi E; bool is_gemm = true;
        g.A = nullptr; g.Bt = nullptr; g.M = T_; g.N = 0; g.K = 1024; g.permA = 0;
        E.mode = 0; E.c1 = E.c2 = 1 << 30; E.ld0 = E.ld1 = E.ld2 = 0; E.sig2 = 0; E.o0 = E.o1 = E.o2 = nullptr; E.gates = (const bf16_t*)P->out; E.gatev = nullptr; E.cw = E.cb = nullptr;
        switch (ph) {
        case 2: g.A = (const bf16_t*)(ws + WS_HB); g.Bt = (const bf16_t*)(ws + WS_WIN); g.N = INC; g.K = 1024;
                E.mode = pg8::M_ROUTE; E.c1 = SHC; E.c2 = SHC + 512; E.ld0 = SHC; E.ld1 = 512; E.ld2 = 2048; E.sig2 = 1; E.o0 = (bf16_t*)(ws + WS_PR); E.o1 = (bf16_t*)(ws + WS_U5); E.o2 = (bf16_t*)P->out; break;
        case 4: g.A = (const bf16_t*)(ws + WS_LIN); g.Bt = (const bf16_t*)(ws + WS_WLORA); g.N = 1536; g.K = 256;
                E.mode = pg8::M_ROUTE; E.c1 = 512; E.c2 = 1024; E.ld0 = E.ld1 = E.ld2 = 512; E.o0 = (bf16_t*)(ws + WS_E); E.o1 = (bf16_t*)(ws + WS_AA); E.o2 = (bf16_t*)(ws + WS_GG); break;
        case 6: g.A = (const bf16_t*)(ws + WS_U5); g.Bt = (const bf16_t*)(ws + WS_WGLU); g.N = 2048; g.K = 512;
                E.mode = pg8::M_GLU; E.o0 = (bf16_t*)(ws + WS_HB); break;
        case 7: g.A = (const bf16_t*)(ws + WS_YR); g.Bt = (const bf16_t*)(ws + WS_WOR); g.N = 1024; g.K = 512;
                E.mode = pg8::M_MIXADD; E.o0 = (bf16_t*)(ws + WS_HB); break;
        case 8: g.A = (const bf16_t*)(ws + WS_HB); g.Bt = (const bf16_t*)(ws + WS_WOUT); g.N = 1024; g.K = 1024;
                E.mode = pg8::M_SCALE; E.o0 = (bf16_t*)(ws + WS_D1); E.gatev = mod + 2048; break;
        case 10: g.A = (const bf16_t*)(ws + WS_HB); g.Bt = (const bf16_t*)(ws + WS_WUP); g.N = FF2; g.K = 1024; g.permA = 1;
                E.mode = pg8::M_CONV; E.o0 = (bf16_t*)(ws + WS_ACT); E.o1 = (bf16_t*)(ws + WS_HALO); E.cw = P->in[30]; E.cb = P->in[31]; break;
        case 12: g.A = (const bf16_t*)(ws + WS_ACT); g.Bt = (const bf16_t*)(ws + WS_WDN); g.N = 1024; g.K = FF;
                E.mode = pg8::M_SCALE; E.o0 = (bf16_t*)(ws + WS_HB); E.gatev = mod + 5120; break;
        default: is_gemm = false; break;
        }
        if (is_gemm && (PHM & 4u)) {
            int bid = blockIdx.x; LAUNDER_S(bid);
            pg8::StaticOrder S; S.init(g.M, g.N, (int)gridDim.x, bid);
            pg8::gemm_phase(lds, g, S, E);
        } else if (ph == 0 && (PHM & 1u)) {
            phase0(P, lds);
        } else if (ph == 1 && (PHM & 2u)) {
            phase_norm<0>(P->in[0], nullptr, nullptr, P->in[4], mod, 0, 1024, (bf16_t*)(ws + WS_HB), nullptr);
        } else if (ph == 3 && (PHM & 8u)) {
            phase_lora_in(P);
        } else if (ph == 5 && (PHM & 32u)) {
            phase_rwkv(P, lds, !rep);
        } else if (ph == 9 && (PHM & 2u)) {
            phase_norm<2>(P->in[0], (const bf16_t*)(ws + WS_D1), nullptr, P->in[28], mod, 3072, 4096, (bf16_t*)(ws + WS_HB), nullptr);
        } else if (ph == 11 && (PHM & 2048u)) {
            phase_fixup(P);
        } else if (ph == 13 && (PHM & 2u)) {
            phase_norm<1>(P->in[0], (const bf16_t*)(ws + WS_D1), (const bf16_t*)(ws + WS_HB), P->in[33], nullptr, 0, 0, nullptr, P->out);
        }
    }
}

extern "C" void kernel_launch(void* const* d_in, const int* in_sizes, int n_in, void* d_out, int out_size, void* d_ws, size_t ws_size, hipStream_t stream) {
    static int grid = 0;
    if (grid == 0) {
        if (n_in != 34 || in_sizes[0] != T_ * D_ || out_size != T_ * D_ || ws_size < WS_END) {
            fprintf(stderr, "kernel_launch: unexpected shapes: n_in %d in0 %d out %d ws %zu (need %zu)\n", n_in, n_in > 0 ? in_sizes[0] : -1, out_size, ws_size, (size_t)WS_END);
            grid = -1; return; }
        int dev = 0, cus = 0, per_cu = 0;
        (void)hipGetDevice(&dev);
        (void)hipDeviceGetAttribute(&cus, hipDeviceAttributeMultiprocessorCount, dev);
        if (hipFuncSetAttribute((const void*)mk_fwd, hipFuncAttributeMaxDynamicSharedMemorySize, LDS_BYTES) != hipSuccess) fprintf(stderr, "kernel_launch: hipFuncSetAttribute failed\n");
        if (hipOccupancyMaxActiveBlocksPerMultiprocessor(&per_cu, (const void*)mk_fwd, 512, LDS_BYTES) != hipSuccess || per_cu < 1) { fprintf(stderr, "kernel_launch: occupancy query gave %d\n", per_cu); per_cu = 1; }
        (void)hipGetLastError();
        if (cus <= 0) cus = 256;
        grid = cus;
    }
    if (grid < 0) return;
    (void)hipMemsetAsync((char*)d_ws + WS_CTL, 0, XCD_BAR_WORDS * 4, stream);
    Params p{};
    for (int i = 0; i < 34; ++i) p.in[i] = (const float*)d_in[i];
    p.out = (float*)d_out; p.ws = (unsigned char*)d_ws; p.ph_lo = 0; p.ph_hi = NPH;
    void* args[] = {&p};
    hipError_t e = hipLaunchCooperativeKernel((const void*)mk_fwd, dim3(grid), dim3(512), args, LDS_BYTES, stream);
    if (e != hipSuccess) fprintf(stderr, "cooperative launch failed: %s (grid %d)\n", hipGetErrorString(e), grid);
}
```

```cpp
#include <hip/hip_runtime.h>
#include <hip/hip_cooperative_groups.h>
#include <cstdio>
#include <cstdint>
namespace cg = cooperative_groups;

#define LAS __attribute__((address_space(3)))
typedef unsigned short bf16_t;
typedef short bf16x8 __attribute__((ext_vector_type(8)));
typedef float f32x4 __attribute__((ext_vector_type(4)));
typedef float f32x2 __attribute__((ext_vector_type(2)));
typedef unsigned u32x4 __attribute__((ext_vector_type(4)));
typedef unsigned u32x2 __attribute__((ext_vector_type(2)));

constexpr int T_ = 65536, D_ = 1024, SQ = 2048;
constexpr int INC = 4352, SHC = 1792, FF = 2816, FF2 = 5632, MODC = 6144;
constexpr int LDS_BYTES = 147456;
constexpr int LDS_BARW = LDS_BYTES - 16;
constexpr int NPH = 14;
#ifndef PHM
#define PHM 0xFFFFFu
#endif
#ifndef DUP_PHASE
#define DUP_PHASE -1
#endif

constexpr size_t MiB = 1048576;
constexpr size_t WS_CTL = 0;
constexpr size_t WS_MOD = 16384;
constexpr size_t WS_WIN = 1 * MiB;
constexpr size_t WS_WLORA = WS_WIN + (size_t)INC * 1024 * 2;
constexpr size_t WS_WOR = WS_WLORA + (size_t)1536 * 256 * 2;
constexpr size_t WS_WGLU = WS_WOR + (size_t)1024 * 512 * 2;
constexpr size_t WS_WOUT = WS_WGLU + (size_t)2048 * 512 * 2;
constexpr size_t WS_WUP = WS_WOUT + (size_t)1024 * 1024 * 2;
constexpr size_t WS_WDN = WS_WUP + (size_t)FF2 * 1024 * 2;
constexpr size_t WS_WEND = WS_WDN + (size_t)1024 * FF * 2;
static_assert(WS_WEND <= 32 * MiB, "weights overflow");
constexpr size_t WS_HB = 32 * MiB;
constexpr size_t WS_X1 = 160 * MiB;
constexpr size_t WS_PR = WS_X1;
constexpr size_t WS_LIN = WS_X1 + (size_t)T_ * SHC * 2;
constexpr size_t WS_U5 = 416 * MiB;
constexpr size_t WS_E = 480 * MiB;
constexpr size_t WS_AA = 544 * MiB;
constexpr size_t WS_GG = 608 * MiB;
constexpr size_t WS_YR = 672 * MiB;
constexpr size_t WS_D1 = WS_X1;
constexpr size_t WS_ACT = 416 * MiB;
constexpr size_t WS_HALO = 768 * MiB;
constexpr size_t WS_END = 944 * MiB;

struct Params {
    const float* in[34];
    float* out;
    unsigned char* ws;
    int ph_lo, ph_hi;
};
typedef const __attribute__((address_space(4))) Params* KP;
#define LAUNDER_TID(t) asm volatile("" : "+v"(t))
#define LAUNDER_S(x) asm volatile("" : "+s"(x))

__device__ __forceinline__ unsigned pk2(float lo, float hi) { unsigned r; asm("v_cvt_pk_bf16_f32 %0, %1, %2" : "=v"(r) : "v"(lo), "v"(hi)); return r; }
__device__ __forceinline__ unsigned f2bf(float f) { return pk2(f, 0.f) & 0xFFFFu; }
__device__ __forceinline__ float bf2f(unsigned short b) { return __uint_as_float(((unsigned)b) << 16); }
__device__ __forceinline__ float bflo(unsigned w) { return __uint_as_float(w << 16); }
__device__ __forceinline__ float bfhi(unsigned w) { return __uint_as_float(w & 0xFFFF0000u); }
__device__ __forceinline__ float sigmoidf_(float x) { return __builtin_amdgcn_rcpf(1.0f + __expf(-x)); }
__device__ __forceinline__ float wave_sum(float v) {
    v += __int_as_float(__builtin_amdgcn_update_dpp(0, __float_as_int(v), 0xB1, 0xF, 0xF, false));
    v += __int_as_float(__builtin_amdgcn_update_dpp(0, __float_as_int(v), 0x4E, 0xF, 0xF, false));
    v += __int_as_float(__builtin_amdgcn_update_dpp(0, __float_as_int(v), 0x141, 0xF, 0xF, false));
    v += __int_as_float(__builtin_amdgcn_update_dpp(0, __float_as_int(v), 0x140, 0xF, 0xF, false));
    const int iv = __float_as_int(v);
    const float r0 = __int_as_float(__builtin_amdgcn_readlane(iv, 0)), r1 = __int_as_float(__builtin_amdgcn_readlane(iv, 16));
    const float r2 = __int_as_float(__builtin_amdgcn_readlane(iv, 32)), r3 = __int_as_float(__builtin_amdgcn_readlane(iv, 48));
    return (r0 + r1) + (r2 + r3);
}
#define LDS_FENCE() asm volatile("s_waitcnt lgkmcnt(0)" ::: "memory")


#define XB_TMO      128
#define XB_XCNT(j)  (256  + 64 * (j))
#define XB_XSUB(j)  (1280 + 64 * (j))
#define XB_XGEN(j)  (2304 + 64 * (j))
#define XB_TOP      3328
#define XB_TOPGEN   3392
#define XCD_BAR_WORDS 3456
#define XB_SPIN_CAP (1u << 18)
__device__ __forceinline__ unsigned xb_ld(unsigned* p)              { return __hip_atomic_load(p, __ATOMIC_RELAXED, __HIP_MEMORY_SCOPE_AGENT); }
__device__ __forceinline__ unsigned xb_add(unsigned* p, unsigned v) { return __hip_atomic_fetch_add(p, v, __ATOMIC_RELAXED, __HIP_MEMORY_SCOPE_AGENT); }
__device__ __forceinline__ unsigned xb_xcc_id() { return (unsigned)__builtin_amdgcn_s_getreg((3 << 11) | 20) & 0xFu; }
#define XB_SPIN(cond, bar) do { unsigned _sp = 0; while (cond) { __builtin_amdgcn_s_sleep(1); \
    if ((++_sp & 255u) == 0u) { if (xb_ld(&(bar)[XB_TMO])) break; if (_sp > XB_SPIN_CAP) { atomicAdd(&(bar)[XB_TMO], 1u); break; } } } } while (0)
struct XcdBarrier { unsigned* bar; unsigned x; volatile LAS unsigned* st; };
__device__ __forceinline__ XcdBarrier xcd_barrier_post(unsigned* bar, volatile LAS unsigned* st) {
    XcdBarrier b; b.bar = bar; b.x = xb_xcc_id(); b.st = st;
    if (threadIdx.x == 0) (void)xb_add(&bar[XB_XCNT(b.x)], 1u);
    return b;
}
__device__ __forceinline__ void xcd_barrier_complete(unsigned* bar, unsigned x, unsigned& nloc, unsigned& nx) {
    const unsigned G = gridDim.x * gridDim.y * gridDim.z;
    unsigned sum, cnt, mine, sp = 0u;
    for (;;) {
        sum = 0u; cnt = 0u; mine = 0u;
#pragma unroll
        for (unsigned j = 0; j < 16; ++j) { const unsigned c = xb_ld(&bar[XB_XCNT(j)]); sum += c; cnt += (c > 0u) ? 1u : 0u; mine = (j == x) ? c : mine; }
        if (sum == G) break;
        __builtin_amdgcn_s_sleep(1);
        if ((++sp & 255u) == 0u) { if (xb_ld(&bar[XB_TMO])) break; if (sp > XB_SPIN_CAP) { atomicAdd(&bar[XB_TMO], 1u); break; } }
    }
    nloc = mine > 0u ? mine : 1u; nx = cnt > 0u ? cnt : 1u;
}
__device__ __forceinline__ void xcd_barrier(const XcdBarrier& b) {
    asm volatile("s_waitcnt vmcnt(0)" ::: "memory");
    __syncthreads();
    if (threadIdx.x == 0) {
        unsigned* bar = b.bar;
        __builtin_amdgcn_s_waitcnt(0);
        unsigned nloc = b.st[0], nx = b.st[1];
        if (nloc == 0u) { xcd_barrier_complete(bar, b.x, nloc, nx); b.st[0] = nloc; b.st[1] = nx; }
        const unsigned old = xb_add(&bar[XB_XSUB(b.x)], 1u);
        const unsigned gen = old / nloc;
        if (old + 1u == (gen + 1u) * nloc) {
            __builtin_amdgcn_fence(__ATOMIC_RELEASE, "agent");
            asm volatile("s_waitcnt vmcnt(0)" ::: "memory");
            const unsigned og = xb_add(&bar[XB_TOP], 1u);
            const unsigned tg = og / nx;
            if (og + 1u == (tg + 1u) * nx) xb_add(&bar[XB_TOPGEN], 1u);
            else XB_SPIN(xb_ld(&bar[XB_TOPGEN]) == tg, bar);
            __builtin_amdgcn_fence(__ATOMIC_ACQUIRE, "agent");
            xb_add(&bar[XB_XGEN(b.x)], 1u);
            asm volatile("s_waitcnt vmcnt(0)" ::: "memory");
        } else {
            XB_SPIN(xb_ld(&bar[XB_XGEN(b.x)]) == gen, bar);
            __builtin_amdgcn_fence(__ATOMIC_ACQUIRE, "agent");
            asm volatile("s_waitcnt vmcnt(0)" ::: "memory");
        }
    }
    __syncthreads();
}

namespace pg8 {
constexpr int BM = 256, BK = 64, HALF = 128, HTB = HALF * BK * 2, STAGE_BYTES = 8 * HTB, NXCD = 8, WGM = 8;
__host__ __device__ __forceinline__ int lds_byte(int r, int c) { const int st = (r >> 4) * 2 + (c >> 5), rr = r & 15, cc = c & 31, ob = rr * 64 + cc * 2; return st * 1024 + (ob ^ (((ob >> 9) & 1) << 5)); }
__host__ __device__ __forceinline__ void stage_rc(int b, int& R, int& C) { const int st = b / 1024, sb = b % 1024, swz = sb ^ (((sb >> 9) & 1) << 5); R = (st >> 1) * 16 + swz / 64; C = (st & 1) * 32 + (swz % 64) / 2; }
__host__ __device__ __forceinline__ int perm32(int rho) { const int n = rho >> 4, i = rho & 15; return 8 * (i >> 2) + 4 * n + (i & 3); }

struct Unit { int pm, pn; };
struct Gemm { const bf16_t* A; const bf16_t* Bt; int M, N, K; int permA; };

struct StaticOrder {
    int nM, nN, nwg, G, c;
    __device__ void init(int M, int N, int G_, int c_) { nM = M / BM; nN = N / BM; nwg = nM * nN; G = G_; c = c_; }
    __device__ bool next(int i, Unit& u) const {
        const long L = (long)i * G + c; if (L >= nwg) return false;
        int wgid = (int)L; { const int q = nwg / NXCD, r = nwg % NXCD, xcd = wgid % NXCD, off = wgid / NXCD; wgid = (xcd < r ? xcd * (q + 1) : r * (q + 1) + (xcd - r) * q) + off; }
        const int nig = WGM * nN, gid = wgid / nig, fm = gid * WGM, gsz = (nM - fm) < WGM ? (nM - fm) : WGM;
        u.pm = fm + ((wgid % nig) % gsz); u.pn = (wgid % nig) / gsz; return true;
    }
};

enum { M_ROUTE = 0, M_GLU, M_MIXADD, M_SCALE, M_CONV };
struct Epi {
    int mode;
    int c1, c2, ld0, ld1, ld2, sig2;
    bf16_t *o0, *o1, *o2;
    const bf16_t* gates;
    const float* gatev;
    const float *cw, *cb;
    __device__ __forceinline__ void operator()(const f32x4 (&acc)[2][2][4][2], const Unit& u, int wr, int wc, int fr, int fq) const {
        const int row0 = u.pm * BM + wr * 64 + fr;
        if (mode == M_ROUTE) {
            const int colt = u.pn * BM; bf16_t* base; int ld, cb; bool sig = false;
            if (colt < c1) { base = o0; ld = ld0; cb = colt; }
            else if (colt < c2) { base = o1; ld = ld1; cb = colt - c1; }
            else { base = o2; ld = ld2; cb = colt - c2; sig = sig2 != 0; }
            const int col0 = cb + wc * 32 + 8 * fq;
#pragma unroll
            for (int ai = 0; ai < 2; ++ai)
#pragma unroll
                for (int m = 0; m < 4; ++m) { bf16_t* rowp = base + (size_t)(row0 + ai * HALF + m * 16) * ld + col0;
#pragma unroll
                    for (int bj = 0; bj < 2; ++bj) { f32x4 a = acc[ai][bj][m][0], b = acc[ai][bj][m][1];
                        if (sig) {
#pragma unroll
                            for (int i = 0; i < 4; ++i) { a[i] = sigmoidf_(a[i]); b[i] = sigmoidf_(b[i]); } }
                        u32x4 o; o.x = pk2(a[0], a[1]); o.y = pk2(a[2], a[3]); o.z = pk2(b[0], b[1]); o.w = pk2(b[2], b[3]);
                        __builtin_nontemporal_store(o, (u32x4*)(rowp + bj * HALF)); } }
        } else if (mode == M_GLU) {
            const int col0 = u.pn * HALF + wc * 32 + 8 * fq;
            u32x4 gwv[2][4];
#pragma unroll
            for (int ai = 0; ai < 2; ++ai)
#pragma unroll
                for (int m = 0; m < 4; ++m) gwv[ai][m] = *(const u32x4*)(gates + (size_t)(row0 + ai * HALF + m * 16) * 2048 + 1024 + col0);
            __builtin_amdgcn_sched_barrier(0);
#pragma unroll
            for (int ai = 0; ai < 2; ++ai)
#pragma unroll
                for (int m = 0; m < 4; ++m) { const size_t row = (size_t)(row0 + ai * HALF + m * 16);
                    const u32x4 gw = gwv[ai][m];
                    const f32x4 ga0 = acc[ai][0][m][0], ga1 = acc[ai][0][m][1], gb0 = acc[ai][1][m][0], gb1 = acc[ai][1][m][1];
                    float r[8];
                    r[0] = ga0[0] * sigmoidf_(gb0[0]) * bflo(gw.x); r[1] = ga0[1] * sigmoidf_(gb0[1]) * bfhi(gw.x);
                    r[2] = ga0[2] * sigmoidf_(gb0[2]) * bflo(gw.y); r[3] = ga0[3] * sigmoidf_(gb0[3]) * bfhi(gw.y);
                    r[4] = ga1[0] * sigmoidf_(gb1[0]) * bflo(gw.z); r[5] = ga1[1] * sigmoidf_(gb1[1]) * bfhi(gw.z);
                    r[6] = ga1[2] * sigmoidf_(gb1[2]) * bflo(gw.w); r[7] = ga1[3] * sigmoidf_(gb1[3]) * bfhi(gw.w);
                    u32x4 o; o.x = pk2(r[0], r[1]); o.y = pk2(r[2], r[3]); o.z = pk2(r[4], r[5]); o.w = pk2(r[6], r[7]);
                    *(u32x4*)(o0 + row * 1024 + col0) = o; }
        } else if (mode == M_MIXADD) {
            const int col0 = u.pn * BM + wc * 32 + 8 * fq;
#pragma unroll
            for (int ai = 0; ai < 2; ++ai) {
                u32x4 gwv[4][2], mov[4][2];
#pragma unroll
                for (int m = 0; m < 4; ++m)
#pragma unroll
                    for (int bj = 0; bj < 2; ++bj) { const size_t row = (size_t)(row0 + ai * HALF + m * 16); const int col = col0 + bj * HALF;
                        gwv[m][bj] = *(const u32x4*)(gates + row * 2048 + col); mov[m][bj] = *(const u32x4*)(o0 + row * 1024 + col); }
                __builtin_amdgcn_sched_barrier(0);
#pragma unroll
                for (int m = 0; m < 4; ++m)
#pragma unroll
                    for (int bj = 0; bj < 2; ++bj) { const size_t row = (size_t)(row0 + ai * HALF + m * 16); const int col = col0 + bj * HALF;
                        const u32x4 gw = gwv[m][bj], mo = mov[m][bj];
                        const f32x4 a = acc[ai][bj][m][0], b = acc[ai][bj][m][1];
                        u32x4 o;
                        o.x = pk2(bflo(mo.x) + bflo(gw.x) * a[0], bfhi(mo.x) + bfhi(gw.x) * a[1]);
                        o.y = pk2(bflo(mo.y) + bflo(gw.y) * a[2], bfhi(mo.y) + bfhi(gw.y) * a[3]);
                        o.z = pk2(bflo(mo.z) + bflo(gw.z) * b[0], bfhi(mo.z) + bfhi(gw.z) * b[1]);
                        o.w = pk2(bflo(mo.w) + bflo(gw.w) * b[2], bfhi(mo.w) + bfhi(gw.w) * b[3]);
                        *(u32x4*)(o0 + row * 1024 + col) = o; }
            }
        } else if (mode == M_CONV) {
            const int jc = wc * 32 + 8 * fq, oc0 = u.pn * HALF + jc;
            const int rbase = u.pm * BM + wr * 64 + 4 * fr;
#pragma unroll
            for (int n = 0; n < 2; ++n) {
                const int oc = oc0 + 4 * n;
                f32x4 sg[2][4];
#pragma unroll
                for (int bj = 0; bj < 2; ++bj) {
                    const int wo = bj * FF + oc;
                    const f32x4 w0 = *(const f32x4*)(cw + wo), w1 = *(const f32x4*)(cw + FF2 + wo), w2 = *(const f32x4*)(cw + 2 * FF2 + wo), bb = *(const f32x4*)(cb + wo);
#pragma unroll
                    for (int ai = 0; ai < 2; ++ai) {
                        const f32x4 c0 = acc[ai][bj][0][n], c1 = acc[ai][bj][1][n], c2 = acc[ai][bj][2][n], c3 = acc[ai][bj][3][n];
                        f32x4 p3, p2;
#pragma unroll
                        for (int i = 0; i < 4; ++i) {
                            p3[i] = __int_as_float(__builtin_amdgcn_update_dpp(0, __float_as_int(c3[i]), 0x111, 0xF, 0xF, true));
                            p2[i] = __int_as_float(__builtin_amdgcn_update_dpp(0, __float_as_int(c2[i]), 0x111, 0xF, 0xF, true));
                        }
                        f32x4 ov[4];
                        ov[0] = bb + w2 * c0 + w1 * p3 + w0 * p2; ov[1] = bb + w2 * c1 + w1 * c0 + w0 * p3; ov[2] = bb + w2 * c2 + w1 * c1 + w0 * c0; ov[3] = bb + w2 * c3 + w1 * c2 + w0 * c1;
                        if (fr == 0 || fr == 15) {
                            const int blk = u.pm * 4 + ai * 2 + wr;
                            const f32x4 h0 = fr == 0 ? c0 : c2, h1 = fr == 0 ? c1 : c3;
                            bf16_t* hp = o1 + ((size_t)blk * 4 + (fr == 0 ? 0 : 2)) * FF2 + u.pn * BM + bj * HALF + jc + 4 * n;
                            u32x2 a; a.x = pk2(h0[0], h0[1]); a.y = pk2(h0[2], h0[3]); *(u32x2*)hp = a;
                            u32x2 b; b.x = pk2(h1[0], h1[1]); b.y = pk2(h1[2], h1[3]); *(u32x2*)(hp + FF2) = b;
                        }
                        if (bj == 0) {
#pragma unroll
                            for (int m = 0; m < 4; ++m)
#pragma unroll
                                for (int i = 0; i < 4; ++i) sg[ai][m][i] = ov[m][i] * sigmoidf_(ov[m][i]);
                        } else {
#pragma unroll
                            for (int m = 0; m < 4; ++m) { const f32x4 r = sg[ai][m] * ov[m];
                                u32x2 o; o.x = pk2(r[0], r[1]); o.y = pk2(r[2], r[3]);
                                *(u32x2*)(o0 + (size_t)(rbase + ai * HALF + m) * FF + oc) = o; }
                        }
                    }
                }
            }
        } else {
            const int col0 = u.pn * BM + wc * 32 + 8 * fq;
            const int bidx = (u.pm * BM) >> 11;
            f32x4 gv[2][2];
#pragma unroll
            for (int bj = 0; bj < 2; ++bj)
#pragma unroll
                for (int n = 0; n < 2; ++n) gv[bj][n] = *(const f32x4*)(gatev + (size_t)bidx * MODC + col0 + bj * HALF + 4 * n);
#pragma unroll
            for (int ai = 0; ai < 2; ++ai)
#pragma unroll
                for (int m = 0; m < 4; ++m) { bf16_t* rowp = o0 + (size_t)(row0 + ai * HALF + m * 16) * 1024 + col0;
#pragma unroll
                    for (int bj = 0; bj < 2; ++bj) { const f32x4 a = acc[ai][bj][m][0] * gv[bj][0], b = acc[ai][bj][m][1] * gv[bj][1];
                        u32x4 o; o.x = pk2(a[0], a[1]); o.y = pk2(a[2], a[3]); o.z = pk2(b[0], b[1]); o.w = pk2(b[2], b[3]);
                        *(u32x4*)(rowp + bj * HALF) = o; } }
        }
    }
};

__device__ __forceinline__ void gemm_phase(LAS unsigned char* lds, const Gemm g, const StaticOrder& S, const Epi& E) {
    int tid = threadIdx.x; LAUNDER_TID(tid);
    const int wid = __builtin_amdgcn_readfirstlane(tid >> 6), lane = tid & 63, wr = wid >> 2, wc = wid & 3, fr = lane & 15, fq = lane >> 4;
    const int K = g.K, nt = K / BK;
    unsigned voffA[2], voffB[2];
#pragma unroll
    for (int i = 0; i < 2; ++i) { int R, C; stage_rc(tid * 16 + i * 8192, R, C); const int Rb = (R & ~31) + perm32(R & 31);
        const int Ra = g.permA ? ((R & ~63) + 4 * (R & 15) + ((R >> 4) & 3)) : R;
        voffA[i] = (unsigned)(Ra * K + C) * 2u; voffB[i] = (unsigned)(Rb * K + C) * 2u; }
    const size_t kstep = (size_t)(BK * 2);
    const size_t hstep = (size_t)HALF * K * 2;
    const size_t tstep = 2 * hstep;
    const unsigned ldsw = (unsigned)wid * 1024u;
    const int aoff = lds_byte(wr * 64 + fr, fq * 8), boff = lds_byte(wc * 32 + fr, fq * 8);
#define PG8_SA(b, h) (((b) * 2 + (h)) * HTB)
#define PG8_SB(b, h) ((4 + (b) * 2 + (h)) * HTB)
#define PG8_STAGE(bufoff, gbase, voff) do { _Pragma("unroll") for (int _i = 0; _i < 2; ++_i) \
        __builtin_amdgcn_global_load_lds((const unsigned*)((const char*)(gbase) + (voff)[_i]), (LAS unsigned*)(lds + (bufoff) + ldsw + _i * 8192), 16, 0, 0); } while (0)
#define PG8_LDA(dst, b, h) do { _Pragma("unroll") for (int m = 0; m < 4; ++m) _Pragma("unroll") for (int k = 0; k < 2; ++k) dst[m][k] = *(const LAS bf16x8*)(lds + PG8_SA(b, h) + aoff + m * 2048 + k * 1024); } while (0)
#define PG8_LDB(dst, b, h) do { _Pragma("unroll") for (int n = 0; n < 2; ++n) _Pragma("unroll") for (int k = 0; k < 2; ++k) dst[n][k] = *(const LAS bf16x8*)(lds + PG8_SB(b, h) + boff + n * 2048 + k * 1024); } while (0)
#define PG8_MMA(ai, bj, At, Bt) do { __builtin_amdgcn_s_setprio(1); _Pragma("unroll") for (int m = 0; m < 4; ++m) _Pragma("unroll") for (int n = 0; n < 2; ++n) _Pragma("unroll") for (int k = 0; k < 2; ++k) \
        acc[ai][bj][m][n] = __builtin_amdgcn_mfma_f32_16x16x32_bf16(Bt[n][k], At[m][k], acc[ai][bj][m][n], 0, 0, 0); __builtin_amdgcn_s_setprio(0); } while (0)
#define PG8_WAIT_V(n) asm volatile("s_waitcnt vmcnt(" #n ")" ::: "memory")
#define PG8_WAIT_L(n) asm volatile("s_waitcnt lgkmcnt(" #n ")" ::: "memory")
#define PG8_BAR __builtin_amdgcn_s_barrier()
#define PG8_SCHED __builtin_amdgcn_sched_barrier(0)
    Unit cur, nxt; int ui = 0;
    if (!S.next(0, cur)) return;
    f32x4 acc[2][2][4][2];
#pragma unroll
    for (int a = 0; a < 2; ++a)
#pragma unroll
        for (int b = 0; b < 2; ++b)
#pragma unroll
            for (int m = 0; m < 4; ++m)
#pragma unroll
                for (int n = 0; n < 2; ++n) acc[a][b][m][n] = (f32x4){0.f, 0.f, 0.f, 0.f};
    bf16x8 At[4][2], B0[2][2], B1[2][2];
    const char* cA = (const char*)g.A + (size_t)cur.pm * tstep; const char* cB = (const char*)g.Bt + (size_t)cur.pn * tstep;
    PG8_STAGE(PG8_SB(0, 0), cB, voffB); PG8_STAGE(PG8_SB(0, 1), cB + hstep, voffB); PG8_STAGE(PG8_SA(0, 0), cA, voffA); PG8_STAGE(PG8_SA(0, 1), cA + hstep, voffA);
    if (wr == 1) PG8_BAR;
    PG8_WAIT_V(2); PG8_BAR;
    PG8_STAGE(PG8_SB(1, 0), cB + kstep, voffB); PG8_STAGE(PG8_SA(1, 0), cA + kstep, voffA); PG8_STAGE(PG8_SB(1, 1), cB + hstep + kstep, voffB);
    PG8_WAIT_V(6); PG8_BAR;
    for (;;) {
        const bool has_next = S.next(ui + 1, nxt);
        const char* nA = has_next ? (const char*)g.A + (size_t)nxt.pm * tstep : cA; const char* nB = has_next ? (const char*)g.Bt + (size_t)nxt.pn * tstep : cB;
        for (int t = 0; t < nt; t += 2) {
            const bool last = (t == nt - 2);
            const char* a1 = cA + (size_t)(t + 1) * kstep;
            const char* a2 = last ? nA : cA + (size_t)(t + 2) * kstep; const char* b2 = last ? nB : cB + (size_t)(t + 2) * kstep;
            const char* a3 = a2 + kstep; const char* b3 = b2 + kstep;
            PG8_LDB(B0, 0, 0); PG8_LDB(B1, 0, 1); PG8_SCHED; PG8_LDA(At, 0, 0); PG8_STAGE(PG8_SA(1, 1), a1 + hstep, voffA);
            PG8_WAIT_V(8); PG8_WAIT_L(0); PG8_BAR; PG8_MMA(0, 0, At, B0); PG8_MMA(0, 1, At, B1); PG8_BAR; PG8_SCHED;
            PG8_LDA(At, 0, 1); PG8_STAGE(PG8_SB(0, 0), b2, voffB); PG8_STAGE(PG8_SB(0, 1), b2 + hstep, voffB); PG8_STAGE(PG8_SA(0, 0), a2, voffA);
            PG8_WAIT_V(8); PG8_WAIT_L(0); PG8_BAR; PG8_MMA(1, 0, At, B0); PG8_MMA(1, 1, At, B1); PG8_BAR; PG8_SCHED;
            PG8_LDB(B0, 1, 0); PG8_LDB(B1, 1, 1); PG8_SCHED; PG8_LDA(At, 1, 0); PG8_STAGE(PG8_SA(0, 1), a2 + hstep, voffA);
            PG8_WAIT_V(8); PG8_WAIT_L(0); PG8_BAR; PG8_MMA(0, 0, At, B0); PG8_MMA(0, 1, At, B1); PG8_BAR; PG8_SCHED;
            PG8_LDA(At, 1, 1); PG8_STAGE(PG8_SB(1, 0), b3, voffB); PG8_STAGE(PG8_SB(1, 1), b3 + hstep, voffB); PG8_STAGE(PG8_SA(1, 0), a3, voffA);
            PG8_WAIT_V(8); PG8_WAIT_L(0); PG8_BAR; PG8_MMA(1, 0, At, B0); PG8_MMA(1, 1, At, B1); PG8_BAR; PG8_SCHED;
        }
        if (wr == 0) PG8_BAR;
        E(acc, cur, wr, wc, fr, fq);
        if (!has_next) break;
#pragma unroll
        for (int a = 0; a < 2; ++a)
#pragma unroll
            for (int b = 0; b < 2; ++b)
#pragma unroll
                for (int m = 0; m < 4; ++m)
#pragma unroll
                    for (int n = 0; n < 2; ++n) acc[a][b][m][n] = (f32x4){0.f, 0.f, 0.f, 0.f};
        cur = nxt; cA = nA; cB = nB; ++ui;
        if (wr == 1) PG8_BAR;
    }
    PG8_WAIT_V(0);
    PG8_BAR;
#undef PG8_SA
#undef PG8_SB
#undef PG8_STAGE
#undef PG8_LDA
#undef PG8_LDB
#undef PG8_MMA
#undef PG8_WAIT_V
#undef PG8_WAIT_L
#undef PG8_BAR
#undef PG8_SCHED
}
}

__device__ __forceinline__ int rowmap(int map, int n) {
    if (map == 0) return n;
    const int half = map == 1 ? 1024 : FF;
    const int hi = n >= half ? 1 : 0, nn = n - hi * half;
    return 256 * (nn >> 7) + 128 * hi + (nn & 127);
}
__device__ __forceinline__ void transpose_item(const float* __restrict__ W, int K, int N, bf16_t* WT, int map, LAS float* scr, int item, int lane) {
    const int nblk = N / 32, kb = item / nblk, nb = item % nblk, k0 = 64 * kb, n0 = 32 * nb;
#pragma unroll 8
    for (int i = 0; i < 32; ++i) { const int kk = 2 * i + (lane >> 5); scr[kk * 33 + (lane & 31)] = W[(size_t)(k0 + kk) * N + n0 + (lane & 31)]; }
    LDS_FENCE();
    const int c = lane & 7;
#pragma unroll
    for (int j = 0; j < 4; ++j) { const int n = (lane >> 3) + 8 * j; const LAS float* s = scr + (8 * c) * 33 + n;
        u32x4 o; o.x = pk2(s[0 * 33], s[1 * 33]); o.y = pk2(s[2 * 33], s[3 * 33]); o.z = pk2(s[4 * 33], s[5 * 33]); o.w = pk2(s[6 * 33], s[7 * 33]);
        *(u32x4*)(WT + (size_t)rowmap(map, n0 + n) * K + k0 + 8 * c) = o; }
    LDS_FENCE();
}

__device__ __forceinline__ void phase0(KP P, LAS unsigned char* lds) {
    int tid = threadIdx.x; LAUNDER_TID(tid); int bid = blockIdx.x; LAUNDER_S(bid);
    const int lane = tid & 63, wave = tid >> 6;
    const int gw = bid * 8 + wave, NGW = gridDim.x * 8;
    unsigned char* ws = P->ws;
    LAS float* sc = (LAS float*)lds;
    const float* c = P->in[1];
    for (int i = tid; i < 32 * 1024; i += 512) { const float v = c[i]; sc[i] = v * sigmoidf_(v); }
    __syncthreads();
    {
        const float* w_ada = P->in[2]; const float* b_ada = P->in[3]; float* mod = (float*)(ws + WS_MOD);
        for (int col = gw; col < MODC; col += NGW) {
            float w[16];
#pragma unroll
            for (int i = 0; i < 16; ++i) w[i] = w_ada[(size_t)(lane + 64 * i) * MODC + col];
            float keep = 0.f;
            for (int b = 0; b < 32; ++b) {
                float s = 0.f;
#pragma unroll
                for (int i = 0; i < 16; ++i) s += sc[b * 1024 + lane + 64 * i] * w[i];
                s = wave_sum(s);
                keep = (lane == b) ? s : keep;
            }
            if (lane < 32) mod[(size_t)lane * MODC + col] = keep + b_ada[col];
        }
    }
    asm volatile("s_waitcnt vmcnt(0)" ::: "memory");
    __syncthreads();
    if (tid == 0) {
        __builtin_amdgcn_fence(__ATOMIC_RELEASE, "agent");
        asm volatile("s_waitcnt vmcnt(0)" ::: "memory");
        (void)xb_add((unsigned*)(ws + WS_CTL), 1u);
    }
    {
        LAS float* scr = (LAS float*)(lds + wave * 8448);
        constexpr int I_IN = (1024 / 64) * (INC / 32), I_OR = (512 / 64) * (1024 / 32), I_GLU = (512 / 64) * (2048 / 32), I_OUT = (1024 / 64) * (1024 / 32),
                      I_UP = (1024 / 64) * (FF2 / 32), I_DN = (FF / 64) * (1024 / 32);
        constexpr int NITEMS = I_IN + I_OR + I_GLU + I_OUT + I_UP + I_DN;
        for (int it = gw; it < NITEMS; it += NGW) {
            int r = it;
            if (r < I_IN) { transpose_item(P->in[5], 1024, INC, (bf16_t*)(ws + WS_WIN), 0, scr, r, lane); continue; } r -= I_IN;
            if (r < I_OR) { transpose_item(P->in[17], 512, 1024, (bf16_t*)(ws + WS_WOR), 0, scr, r, lane); continue; } r -= I_OR;
            if (r < I_GLU) { transpose_item(P->in[26], 512, 2048, (bf16_t*)(ws + WS_WGLU), 1, scr, r, lane); continue; } r -= I_GLU;
            if (r < I_OUT) { transpose_item(P->in[27], 1024, 1024, (bf16_t*)(ws + WS_WOUT), 0, scr, r, lane); continue; } r -= I_OUT;
            if (r < I_UP) { transpose_item(P->in[29], 1024, FF2, (bf16_t*)(ws + WS_WUP), 2, scr, r, lane); continue; } r -= I_UP;
            transpose_item(P->in[32], FF, 1024, (bf16_t*)(ws + WS_WDN), 0, scr, r, lane);
        }
    }
    {
        bf16_t* wl = (bf16_t*)(ws + WS_WLORA);
        const float* w_up = P->in[8]; const float* a_up = P->in[10]; const float* g_up = P->in[11];
        for (int idx = bid * 512 + tid; idx < 1536 * 256; idx += gridDim.x * 512) {
            const int n = idx >> 8, k = idx & 255, which = n >> 9, nn = n & 511;
            float v = 0.f;
            if (which == 0) { if (k < 64) v = w_up[k * 512 + nn]; }
            else if (which == 1) { if (k >= 64 && k < 128) v = a_up[(k - 64) * 512 + nn]; }
            else { if (k >= 128) v = g_up[(k - 128) * 512 + nn]; }
            wl[idx] = (bf16_t)f2bf(v);
        }
    }
}

template <int MODE>
__device__ __forceinline__ void phase_norm(const float* X, const bf16_t* dl, const bf16_t* dl2, const float* g, const float* mod, int sh_off, int sc_off, bf16_t* outb, float* outf) {
    int tid = threadIdx.x; LAUNDER_TID(tid); int bid = blockIdx.x; LAUNDER_S(bid);
    const int lane = tid & 63, wave = tid >> 6;
    const int gw = bid * 8 + wave, NGW = gridDim.x * 8;
    f32x4 gg[4];
#pragma unroll
    for (int j = 0; j < 4; ++j) gg[j] = *(const f32x4*)(g + lane * 4 + 256 * j);
    for (int rp = gw; rp < T_ / 2; rp += NGW) {
        f32x4 v[2][4]; u32x2 dw[2][4], dw2[2][4];
#pragma unroll
        for (int r = 0; r < 2; ++r) {
            const size_t row = (size_t)(2 * rp + r);
            const f32x4* xr = (const f32x4*)(X + row * 1024) + lane;
#pragma unroll
            for (int j = 0; j < 4; ++j) v[r][j] = xr[64 * j];
            if (MODE != 0) {
#pragma unroll
                for (int j = 0; j < 4; ++j) dw[r][j] = *(const u32x2*)(dl + row * 1024 + lane * 4 + 256 * j);
            }
            if (MODE == 1) {
#pragma unroll
                for (int j = 0; j < 4; ++j) dw2[r][j] = *(const u32x2*)(dl2 + row * 1024 + lane * 4 + 256 * j);
            }
        }
#pragma unroll
        for (int r = 0; r < 2; ++r) {
            const size_t row = (size_t)(2 * rp + r);
            float ss = 0.f;
#pragma unroll
            for (int j = 0; j < 4; ++j) {
                if (MODE != 0) { v[r][j].x += bflo(dw[r][j].x); v[r][j].y += bfhi(dw[r][j].x); v[r][j].z += bflo(dw[r][j].y); v[r][j].w += bfhi(dw[r][j].y); }
                if (MODE == 1) { v[r][j].x += bflo(dw2[r][j].x); v[r][j].y += bfhi(dw2[r][j].x); v[r][j].z += bflo(dw2[r][j].y); v[r][j].w += bfhi(dw2[r][j].y); }
                ss += (v[r][j].x * v[r][j].x + v[r][j].y * v[r][j].y) + (v[r][j].z * v[r][j].z + v[r][j].w * v[r][j].w);
            }
            ss = wave_sum(ss);
            const float inv = rsqrtf(ss * (1.0f / 1024.0f) + 1e-6f);
            if (MODE != 1) {
                const int b = (int)(row >> 11);
#pragma unroll
                for (int j = 0; j < 4; ++j) { const int col = lane * 4 + 256 * j;
                    const f32x4 sc = *(const f32x4*)(mod + (size_t)b * MODC + sc_off + col), sh = *(const f32x4*)(mod + (size_t)b * MODC + sh_off + col);
                    const f32x4 o = v[r][j] * inv * gg[j] * (sc + 1.0f) + sh;
                    u32x2 w; w.x = pk2(o.x, o.y); w.y = pk2(o.z, o.w);
                    *(u32x2*)(outb + row * 1024 + col) = w;
                    }
            } else {
#pragma unroll
                for (int j = 0; j < 4; ++j) { const int col = lane * 4 + 256 * j;
                    *(f32x4*)(outf + row * 1024 + col) = v[r][j] * inv * gg[j]; }
            }
        }
    }
}

__device__ __forceinline__ float gelu_tanh(float x) {
    const float u = 0.7978845608f * (x + 0.044715f * x * x * x);
    const float e = __expf(2.0f * u);
    const float t = 1.0f - 2.0f * __builtin_amdgcn_rcpf(1.0f + e);
    return 0.5f * x * (1.0f + t);
}
__device__ __forceinline__ void s5_q(const float* a_re, const float* a_im, float dt, int idx, float& qre, float& qim) {
    const float are = a_re[idx], aim = a_im[idx];
    const float zre = are * dt, zim = aim * dt, mag = expf(zre);
    const float abre = mag * cosf(zim), abim = mag * sinf(zim);
    const float den = are * are + aim * aim;
    qre = ((abre - 1.0f) * are + abim * aim) / den;
    qim = (abim * are - (abre - 1.0f) * aim) / den;
}
struct S5Regs { bf16x8 af; float ar, ai, dval, xr, xi; size_t ubase; };
__device__ __forceinline__ void s5_setup(KP P, int b, int g, int lane, S5Regs& R, LAS bf16_t* BB) {
    const bf16_t* U = (const bf16_t*)(P->ws + WS_U5);
    const int l15 = lane & 15, quad = lane >> 4;
    const float dt = expf(P->in[20][g]);
    { const float are = P->in[18][g * 64 + lane], aim = P->in[19][g * 64 + lane]; const float mag = expf(are * dt); R.ar = mag * cosf(aim * dt); R.ai = mag * sinf(aim * dt); }
#pragma unroll
    for (int pt = 0; pt < 4; ++pt) {
        const int pp = pt * 16 + l15;
        float qre, qim; s5_q(P->in[18], P->in[19], dt, g * 64 + pp, qre, qim);
        bf16x8 fre, fim;
#pragma unroll
        for (int j = 0; j < 8; ++j) {
            float vre = 0.f, vim = 0.f;
            if (quad < 2) { const int cidx = (g * 64 + pp) * 16 + quad * 8 + j; const float bre = P->in[21][cidx], bim = P->in[22][cidx];
                vre = qre * bre - qim * bim; vim = qre * bim + qim * bre; }
            fre[j] = (short)f2bf(vre); fim[j] = (short)f2bf(vim);
        }
        if (quad < 2) { *(LAS bf16x8*)(BB + (pp) * 16 + quad * 8) = fre; *(LAS bf16x8*)(BB + (64 + pp) * 16 + quad * 8) = fim; }
    }
#pragma unroll
    for (int kk = 0; kk < 4; ++kk) {
        bf16x8 f;
#pragma unroll
        for (int j = 0; j < 8; ++j) { const int k = kk * 32 + quad * 8 + j;
            const float v = k < 64 ? P->in[23][(g * 16 + l15) * 64 + k] : -P->in[24][(g * 16 + l15) * 64 + (k - 64)];
            f[j] = (short)f2bf(v); }
        *(LAS bf16x8*)(BB + 128 * 16 + l15 * 128 + kk * 32 + quad * 8) = f;
    }
    R.dval = P->in[25][g * 16 + l15];
    R.xr = 0.f; R.xi = 0.f;
    R.ubase = (size_t)b * SQ * 512 + g * 16;
    R.af = (bf16x8){0, 0, 0, 0, 0, 0, 0, 0};
    if (quad < 2) R.af = *(const bf16x8*)(U + R.ubase + (size_t)l15 * 512 + quad * 8);
}
__device__ __forceinline__ void s5_chunk(KP P, S5Regs& R, int ck, LAS float* BU, LAS bf16_t* XB, const LAS bf16_t* BB, int lane) {
    bf16_t* U = (bf16_t*)(P->ws + WS_U5);
    const int l15 = lane & 15, quad = lane >> 4;
    const int t0 = ck * 16;
    bf16x8 afn = (bf16x8){0, 0, 0, 0, 0, 0, 0, 0};
    if (quad < 2 && ck + 1 < SQ / 16) afn = *(const bf16x8*)(U + R.ubase + (size_t)(t0 + 16 + l15) * 512 + quad * 8);
    float uo[4];
#pragma unroll
    for (int j = 0; j < 4; ++j) uo[j] = bf2f(U[R.ubase + (size_t)(t0 + quad * 4 + j) * 512 + l15]);
#pragma unroll
    for (int q = 0; q < 8; ++q) {
        const bf16x8 bq = *(const LAS bf16x8*)(BB + (q * 16 + l15) * 16 + (quad & 1) * 8);
        f32x4 d = __builtin_amdgcn_mfma_f32_16x16x32_bf16(R.af, bq, (f32x4){0.f, 0.f, 0.f, 0.f}, 0, 0, 0);
#pragma unroll
        for (int j = 0; j < 4; ++j) BU[(quad * 4 + j) * 128 + q * 16 + l15] = d[j];
    }
    LDS_FENCE();
    float xr = R.xr, xi = R.xi;
#pragma unroll
    for (int tt = 0; tt < 16; ++tt) {
        const float bre = BU[tt * 128 + lane], bim = BU[tt * 128 + 64 + lane];
        const float nr = R.ar * xr - R.ai * xi + bre, ni = R.ar * xi + R.ai * xr + bim;
        xr = nr; xi = ni;
        XB[tt * 136 + lane] = (bf16_t)f2bf(xr); XB[tt * 136 + 64 + lane] = (bf16_t)f2bf(xi);
    }
    R.xr = xr; R.xi = xi;
    LDS_FENCE();
    f32x4 y = (f32x4){0.f, 0.f, 0.f, 0.f};
#pragma unroll
    for (int kk = 0; kk < 4; ++kk) {
        const bf16x8 a2 = *(const LAS bf16x8*)(XB + l15 * 136 + kk * 32 + quad * 8);
        const bf16x8 cmk = *(const LAS bf16x8*)(BB + 128 * 16 + l15 * 128 + kk * 32 + quad * 8);
        y = __builtin_amdgcn_mfma_f32_16x16x32_bf16(a2, cmk, y, 0, 0, 0);
    }
#pragma unroll
    for (int j = 0; j < 4; ++j) {
        const float yv = y[j] + R.dval * uo[j];
        U[R.ubase + (size_t)(t0 + quad * 4 + j) * 512 + l15] = (bf16_t)f2bf(gelu_tanh(yv));
    }
    LDS_FENCE();
    R.af = afn;
}
__device__ __forceinline__ void phase_lora_in(KP P) {
    int tid = threadIdx.x; LAUNDER_TID(tid); int bid = blockIdx.x; LAUNDER_S(bid);
    const int lane = tid & 63, wave = tid >> 6;
    unsigned char* ws = P->ws;
    const bf16_t* PR = (const bf16_t*)(ws + WS_PR); bf16_t* LIN = (bf16_t*)(ws + WS_LIN);
    const f32x4 mu = *(const f32x4*)(P->in[6] + 1536 + lane * 4);
    for (int row = bid * 8 + wave; row < T_; row += gridDim.x * 8) {
        const u32x2 cw = *(const u32x2*)(PR + (size_t)row * SHC + 1536 + lane * 4);
        u32x2 pw; pw.x = 0u; pw.y = 0u;
        if ((row & (SQ - 1)) != 0) pw = *(const u32x2*)(PR + (size_t)(row - 1) * SHC + 1536 + lane * 4);
        float cv[4] = {bflo(cw.x), bfhi(cw.x), bflo(cw.y), bfhi(cw.y)}, pv[4] = {bflo(pw.x), bfhi(pw.x), bflo(pw.y), bfhi(pw.y)};
        const float muv[4] = {mu.x, mu.y, mu.z, mu.w};
        float o[4];
#pragma unroll
        for (int i = 0; i < 4; ++i) {
            const float p = cv[i] + (pv[i] - cv[i]) * muv[i];
            const float th = 1.0f - 2.0f * __builtin_amdgcn_rcpf(1.0f + __expf(2.0f * p));
            const float sg = sigmoidf_(p);
            o[i] = lane < 16 ? th : (lane < 32 ? p : sg);
        }
        u32x2 w; w.x = pk2(o[0], o[1]); w.y = pk2(o[2], o[3]);
        *(u32x2*)(LIN + (size_t)row * 256 + lane * 4) = w;
    }
}

constexpr int RW_CH = 16;
constexpr int RW_OPS = 5 * RW_CH * 64 * 4;
constexpr int RW_VC = RW_CH * 64 * 4 + 256;
constexpr int RW_VCOFF = 2 * RW_OPS;
constexpr int RW_YOFF = RW_VCOFF + 3 * RW_VC;
constexpr int RW_S5OFF = RW_YOFF + 2 * RW_CH * 64 * 4;
constexpr int S5_WB = 8192 + 4352 + 4096 + 4096;
static_assert(RW_S5OFF + 4 * S5_WB <= LDS_BARW, "rwkv lds");

struct RwConst { float mur, muk, muv, kkw, kaw, rkw, w0c, a0c, lg, lb; };
struct RwPrepLd { float cr[4], ck[4], cv[4], pr[4], pk[4], pv[4], e[4], a[4]; };
__device__ __forceinline__ void rw_const(KP P, int h, int lane, RwConst& C) {
    const int ch = h * 64 + lane;
    C.mur = P->in[6][ch]; C.muk = P->in[6][512 + ch]; C.muv = P->in[6][1024 + ch];
    C.kkw = P->in[12][ch]; C.kaw = P->in[13][ch]; C.rkw = P->in[14][ch]; C.w0c = P->in[7][ch]; C.a0c = P->in[9][ch];
    C.lg = P->in[15][ch]; C.lb = P->in[16][ch];
}
__device__ __forceinline__ void rw_prep_load(KP P, int b, int h, int chunk, int wl, int lane, RwPrepLd& L) {
    const unsigned char* ws = P->ws;
    const bf16_t* PR = (const bf16_t*)(ws + WS_PR); const bf16_t* E = (const bf16_t*)(ws + WS_E); const bf16_t* AA = (const bf16_t*)(ws + WS_AA);
    const int ch = h * 64 + lane;
#pragma unroll
    for (int i = 0; i < RW_CH / 4; ++i) {
        const int tt = wl + 4 * i, s = chunk * RW_CH + tt; const size_t row = (size_t)b * SQ + s;
        L.cr[i] = bf2f(PR[row * SHC + ch]); L.ck[i] = bf2f(PR[row * SHC + 512 + ch]); L.cv[i] = bf2f(PR[row * SHC + 1024 + ch]);
        const size_t prow = s > 0 ? row - 1 : row;
        L.pr[i] = bf2f(PR[prow * SHC + ch]); L.pk[i] = bf2f(PR[prow * SHC + 512 + ch]); L.pv[i] = bf2f(PR[prow * SHC + 1024 + ch]);
        L.e[i] = bf2f(E[row * 512 + ch]); L.a[i] = bf2f(AA[row * 512 + ch]);
    }
}
__device__ __forceinline__ void rw_prep_compute(LAS unsigned char* opsp, LAS unsigned char* vcp, const RwConst& C, const RwPrepLd& L, int chunk, int wl, int lane) {
    LAS float* Wb = (LAS float*)opsp; LAS float* Ab = Wb + RW_CH * 64; LAS float* Bb = Ab + RW_CH * 64; LAS float* Kb = Bb + RW_CH * 64; LAS float* Rb = Kb + RW_CH * 64; LAS float* Vb = (LAS float*)vcp;
    LAS float* Cf = Vb + RW_CH * 64;
#pragma unroll
    for (int i = 0; i < RW_CH / 4; ++i) {
        const int tt = wl + 4 * i, s = chunk * RW_CH + tt;
        const float pr = s > 0 ? L.pr[i] : 0.f, pk = s > 0 ? L.pk[i] : 0.f, pv = s > 0 ? L.pv[i] : 0.f;
        const float r = L.cr[i] + (pr - L.cr[i]) * C.mur, k = L.ck[i] + (pk - L.ck[i]) * C.muk, v = L.cv[i] + (pv - L.cv[i]) * C.muv;
        const float w = exp2f(-0.87504106f * sigmoidf_(C.w0c + L.e[i]));
        const float a = sigmoidf_(C.a0c + L.a[i]);
        float kk = k * C.kkw;
        const float ss = wave_sum(kk * kk);
        kk *= rsqrtf(ss + 1e-12f);
        const float kmod = k * (1.0f + (a - 1.0f) * C.kaw);
        const float coef = wave_sum(r * kmod * C.rkw);
        Wb[tt * 64 + lane] = w; Ab[tt * 64 + lane] = -kk; Bb[tt * 64 + lane] = kk * a; Kb[tt * 64 + lane] = kmod; Rb[tt * 64 + lane] = r; Vb[tt * 64 + lane] = v;
        if (lane == 0) Cf[tt] = coef;
    }
}
__device__ __forceinline__ void rw_post_load(KP P, int b, int h, int chunk, int wl, int lane, float (&g)[4]) {
    const bf16_t* GG = (const bf16_t*)(P->ws + WS_GG);
    const int ch = h * 64 + lane;
#pragma unroll
    for (int i = 0; i < 4; ++i) { const size_t row = (size_t)b * SQ + chunk * RW_CH + wl + 4 * i; g[i] = bf2f(GG[row * 512 + ch]); }
}
__device__ __forceinline__ void rw_post_compute(KP P, LAS unsigned char* vcp, LAS float* yb, const RwConst& C, const float (&g)[4], int b, int h, int chunk, int wl, int lane) {
    bf16_t* YR = (bf16_t*)(P->ws + WS_YR);
    const int ch = h * 64 + lane;
    LAS float* Vb = (LAS float*)vcp; LAS float* Cf = Vb + RW_CH * 64;
#pragma unroll
    for (int i = 0; i < 4; ++i) {
        const int tt = wl + 4 * i;
        const size_t row = (size_t)b * SQ + chunk * RW_CH + tt;
        const float y = yb[tt * 64 + lane];
        const float mean = wave_sum(y) * (1.0f / 64.0f);
        const float d = y - mean;
        const float var = wave_sum(d * d) * (1.0f / 64.0f);
        const float yn = d * rsqrtf(var + 64e-5f) * C.lg + C.lb;
        YR[row * 512 + ch] = (bf16_t)f2bf((yn + Cf[tt] * Vb[tt * 64 + lane]) * g[i]);
    }
}
__device__ __forceinline__ float dpp_xor1(float v) { return __int_as_float(__builtin_amdgcn_update_dpp(0, __float_as_int(v), 0xB1, 0xF, 0xF, false)); }
__device__ __forceinline__ float dpp_hmirror(float v) { return __int_as_float(__builtin_amdgcn_update_dpp(0, __float_as_int(v), 0x141, 0xF, 0xF, false)); }
__device__ __forceinline__ float dpp_xor2(float v) { return __int_as_float(__builtin_amdgcn_update_dpp(0, __float_as_int(v), 0x4E, 0xF, 0xF, false)); }
__device__ __forceinline__ void phase_rwkv(KP P, LAS unsigned char* lds, bool do_s5) {
    int tid = threadIdx.x; LAUNDER_TID(tid); int bid = blockIdx.x; LAUNDER_S(bid);
    const int lane = tid & 63, wave = __builtin_amdgcn_readfirstlane(tid >> 6);
    constexpr int NCH = SQ / RW_CH;
    for (int bh = bid; bh < 256; bh += gridDim.x) {
        const int b = bh >> 3, h = bh & 7;
        f32x4 S0[2], S1[2];
#pragma unroll
        for (int k = 0; k < 2; ++k) { S0[k] = (f32x4){0.f, 0.f, 0.f, 0.f}; S1[k] = (f32x4){0.f, 0.f, 0.f, 0.f}; }
        const bool helper = wave >= 4;
        const int hj = wave & 3;
        S5Regs R5;
        LAS float* BU5 = (LAS float*)(lds + RW_S5OFF + hj * S5_WB); LAS bf16_t* XB5 = (LAS bf16_t*)(lds + RW_S5OFF + hj * S5_WB + 8192); LAS bf16_t* BB5 = (LAS bf16_t*)(lds + RW_S5OFF + hj * S5_WB + 8192 + 4352);
        RwConst RC; RwPrepLd RL; float gq[4] = {0.f, 0.f, 0.f, 0.f};
        if (helper) { const int chain = bh * 4 + hj; s5_setup(P, chain >> 5, chain & 31, lane, R5, BB5); rw_const(P, h, lane, RC); rw_prep_load(P, b, h, 0, hj, lane, RL); rw_prep_compute(lds, lds + RW_VCOFF, RC, RL, 0, hj, lane); }
        __syncthreads();
        for (int c = 0; c < NCH; ++c) {
            if (!helper) {
                const int ko = lane & 7, rowv = 16 * wave + 2 * (lane >> 3);
                LAS unsigned char* bufp = lds + (c & 1) * RW_OPS;
                const LAS f32x4* W4 = (const LAS f32x4*)bufp + ko * 2; const LAS f32x4* A4 = W4 + RW_CH * 16; const LAS f32x4* B4 = A4 + RW_CH * 16; const LAS f32x4* K4 = B4 + RW_CH * 16; const LAS f32x4* R4 = K4 + RW_CH * 16;
                const LAS f32x2* Vb2 = (const LAS f32x2*)((const LAS float*)(lds + RW_VCOFF + (c % 3) * RW_VC) + rowv);
                LAS f32x2* yb2 = (LAS f32x2*)((LAS float*)(lds + RW_YOFF) + (c & 1) * RW_CH * 64 + rowv);
                f32x4 a[2][2]; f32x2 vv[2];
                f32x4 ew[2][2], eb[2][2], ek[2][2], er[2][2];
                auto issue = [&](int t, int g) {
                    const int p = t & 1, ta = t & (RW_CH - 1);
                    if (g == 0) {
                        a[p][0] = A4[ta * 16]; a[p][1] = A4[ta * 16 + 1];
                        vv[p] = Vb2[ta * 32];
                    } else {
                        const int e = g - 1, o = ta * 16 + e;
                        ew[p][e] = W4[o]; eb[p][e] = B4[o]; ek[p][e] = K4[o]; er[p][e] = R4[o];
                    }
                };
                issue(0, 0); issue(0, 1); issue(0, 2);
#pragma unroll
                for (int tt = 0; tt < RW_CH; ++tt) {
                    const int p = tt & 1;
                    __builtin_amdgcn_sched_barrier(0); issue(tt + 1, 0); __builtin_amdgcn_sched_barrier(0);
                    const float v0 = vv[p].x, v1 = vv[p].y;
                    const f32x4 q0 = S0[0] * a[p][0] + S0[1] * a[p][1], q1 = S1[0] * a[p][0] + S1[1] * a[p][1];
                    float sa0 = (q0.x + q0.y) + (q0.z + q0.w), sa1 = (q1.x + q1.y) + (q1.z + q1.w);
                    sa0 += dpp_xor1(sa0); sa1 += dpp_xor1(sa1); sa0 += dpp_xor2(sa0); sa1 += dpp_xor2(sa1); sa0 += dpp_hmirror(sa0); sa1 += dpp_hmirror(sa1);
                    f32x4 y0 = (f32x4){0.f, 0.f, 0.f, 0.f}, y1 = (f32x4){0.f, 0.f, 0.f, 0.f};
#pragma unroll
                    for (int e = 0; e < 2; ++e) {
                        __builtin_amdgcn_sched_barrier(0); issue(tt + 1, 1 + e); __builtin_amdgcn_sched_barrier(0);
                        S0[e] = S0[e] * ew[p][e] + (eb[p][e] * sa0 + ek[p][e] * v0); y0 += S0[e] * er[p][e];
                        S1[e] = S1[e] * ew[p][e] + (eb[p][e] * sa1 + ek[p][e] * v1); y1 += S1[e] * er[p][e];
                    }
                    __builtin_amdgcn_sched_barrier(0);
                    float r0 = (y0.x + y0.y) + (y0.z + y0.w), r1 = (y1.x + y1.y) + (y1.z + y1.w);
                    r0 += dpp_xor1(r0); r1 += dpp_xor1(r1); r0 += dpp_xor2(r0); r1 += dpp_xor2(r1); r0 += dpp_hmirror(r0); r1 += dpp_hmirror(r1);
                    yb2[tt * 32] = (f32x2){r0, r1};
                }
            } else {
                if (c + 1 < NCH) rw_prep_load(P, b, h, c + 1, hj, lane, RL);
                if (c >= 1) rw_post_load(P, b, h, c - 1, hj, lane, gq);
                if (do_s5) s5_chunk(P, R5, c, BU5, XB5, BB5, lane);
                if (c + 1 < NCH) rw_prep_compute(lds + ((c + 1) & 1) * RW_OPS, lds + RW_VCOFF + ((c + 1) % 3) * RW_VC, RC, RL, c + 1, hj, lane);
                if (c >= 1) rw_post_compute(P, lds + RW_VCOFF + ((c - 1) % 3) * RW_VC, (LAS float*)(lds + RW_YOFF) + ((c - 1) & 1) * RW_CH * 64, RC, gq, b, h, c - 1, hj, lane);
            }
            __syncthreads();
        }
        if (helper) { rw_post_load(P, b, h, NCH - 1, hj, lane, gq); rw_post_compute(P, lds + RW_VCOFF + ((NCH - 1) % 3) * RW_VC, (LAS float*)(lds + RW_YOFF) + ((NCH - 1) & 1) * RW_CH * 64, RC, gq, b, h, NCH - 1, hj, lane); }
        __syncthreads();
    }
}

__device__ __forceinline__ void phase_fixup(KP P) {
    const bf16_t* HALO = (const bf16_t*)(P->ws + WS_HALO); bf16_t* ACT = (bf16_t*)(P->ws + WS_ACT);
    const float* cw = P->in[30]; const float* cb = P->in[31];
    constexpr int NCG = FF / 8, NITEM = (T_ / 64) * NCG;
    int tid = threadIdx.x; LAUNDER_TID(tid); int bid = blockIdx.x; LAUNDER_S(bid);
    for (int it = bid * 512 + tid; it < NITEM; it += gridDim.x * 512) {
        const int cg8 = it % NCG, blk = it / NCG;
        const int oc = cg8 * 8, pn = oc >> 7, j0 = oc & 127;
        const int hg = 256 * pn + j0, hu = hg + 128;
        const bool first = ((blk * 64) & (SQ - 1)) == 0;
        float g[4][8], uu[4][8];
#pragma unroll
        for (int r = 0; r < 4; ++r) {
            const bool z = first && r < 2;
            const size_t hrow = r < 2 ? ((size_t)(z ? blk : blk - 1) * 4 + 2 + r) : ((size_t)blk * 4 + (r - 2));
            const u32x4 a = *(const u32x4*)(HALO + hrow * FF2 + hg), b = *(const u32x4*)(HALO + hrow * FF2 + hu);
            g[r][0] = bflo(a.x); g[r][1] = bfhi(a.x); g[r][2] = bflo(a.y); g[r][3] = bfhi(a.y); g[r][4] = bflo(a.z); g[r][5] = bfhi(a.z); g[r][6] = bflo(a.w); g[r][7] = bfhi(a.w);
            uu[r][0] = bflo(b.x); uu[r][1] = bfhi(b.x); uu[r][2] = bflo(b.y); uu[r][3] = bfhi(b.y); uu[r][4] = bflo(b.z); uu[r][5] = bfhi(b.z); uu[r][6] = bflo(b.w); uu[r][7] = bfhi(b.w);
            if (z) {
#pragma unroll
                for (int i = 0; i < 8; ++i) { g[r][i] = 0.f; uu[r][i] = 0.f; }
            }
        }
#pragma unroll
        for (int rr = 0; rr < 2; ++rr) {
            float o[8];
#pragma unroll
            for (int i = 0; i < 8; ++i) {
                const float gv = cb[oc + i] + cw[oc + i] * g[rr][i] + cw[FF2 + oc + i] * g[rr + 1][i] + cw[2 * FF2 + oc + i] * g[rr + 2][i];
                const float uv = cb[FF + oc + i] + cw[FF + oc + i] * uu[rr][i] + cw[FF2 + FF + oc + i] * uu[rr + 1][i] + cw[2 * FF2 + FF + oc + i] * uu[rr + 2][i];
                o[i] = gv * sigmoidf_(gv) * uv;
            }
            u32x4 ow; ow.x = pk2(o[0], o[1]); ow.y = pk2(o[2], o[3]); ow.z = pk2(o[4], o[5]); ow.w = pk2(o[6], o[7]);
            *(u32x4*)(ACT + ((size_t)blk * 64 + rr) * FF + oc) = ow;
        }
    }
}

__global__ void __launch_bounds__(512, 2) mk_fwd(Params Pv) {
    extern __shared__ __attribute__((aligned(16))) unsigned char shm[];
    LAS unsigned char* lds = (LAS unsigned char*)shm;
    cg::grid_group grid = cg::this_grid();
    const int ph_lo = Pv.ph_lo, ph_hi = Pv.ph_hi;
    volatile LAS unsigned* bst = (volatile LAS unsigned*)(lds + LDS_BARW);
    if (threadIdx.x == 0) { bst[0] = 0u; bst[1] = 0u; }
    __syncthreads();
    const XcdBarrier xbar = xcd_barrier_post((unsigned*)(Pv.ws + WS_CTL), bst);
    for (int phx = ph_lo; phx < ph_hi + (DUP_PHASE >= 0 ? 1 : 0); ++phx) {
        const int ph = (DUP_PHASE >= 0 && phx > DUP_PHASE) ? phx - 1 : phx;
        const bool rep = (DUP_PHASE >= 0 && phx == DUP_PHASE + 1);
        if (phx > ph_lo && !(ph == 1 && DUP_PHASE < 0)) { if (ph_lo < 0) grid.sync(); else xcd_barrier(xbar); }
        KP P = (KP)__builtin_amdgcn_kernarg_segment_ptr(); LAUNDER_S(P);
        unsigned char* ws = P->ws;
        float* mod = (float*)(ws + WS_MOD);
        pg8::Gemm g; pg8::Epi E; bool is_gemm = true;
        g.A = nullptr; g.Bt = nullptr; g.M = T_; g.N = 0; g.K = 1024; g.permA = 0;
        E.mode = 0; E.c1 = E.c2 = 1 << 30; E.ld0 = E.ld1 = E.ld2 = 0; E.sig2 = 0; E.o0 = E.o1 = E.o2 = nullptr; E.gates = (const bf16_t*)P->out; E.gatev = nullptr; E.cw = E.cb = nullptr;
        switch (ph) {
        case 2: g.A = (const bf16_t*)(ws + WS_HB); g.Bt = (const bf16_t*)(ws + WS_WIN); g.N = INC; g.K = 1024;
                E.mode = pg8::M_ROUTE; E.c1 = SHC; E.c2 = SHC + 512; E.ld0 = SHC; E.ld1 = 512; E.ld2 = 2048; E.sig2 = 1; E.o0 = (bf16_t*)(ws + WS_PR); E.o1 = (bf16_t*)(ws + WS_U5); E.o2 = (bf16_t*)P->out; break;
        case 4: g.A = (const bf16_t*)(ws + WS_LIN); g.Bt = (const bf16_t*)(ws + WS_WLORA); g.N = 1536; g.K = 256;
                E.mode = pg8::M_ROUTE; E.c1 = 512; E.c2 = 1024; E.ld0 = E.ld1 = E.ld2 = 512; E.o0 = (bf16_t*)(ws + WS_E); E.o1 = (bf16_t*)(ws + WS_AA); E.o2 = (bf16_t*)(ws + WS_GG); break;
        case 6: g.A = (const bf16_t*)(ws + WS_U5); g.Bt = (const bf16_t*)(ws + WS_WGLU); g.N = 2048; g.K = 512;
                E.mode = pg8::M_GLU; E.o0 = (bf16_t*)(ws + WS_HB); break;
        case 7: g.A = (const bf16_t*)(ws + WS_YR); g.Bt = (const bf16_t*)(ws + WS_WOR); g.N = 1024; g.K = 512;
                E.mode = pg8::M_MIXADD; E.o0 = (bf16_t*)(ws + WS_HB); break;
        case 8: g.A = (const bf16_t*)(ws + WS_HB); g.Bt = (const bf16_t*)(ws + WS_WOUT); g.N = 1024; g.K = 1024;
                E.mode = pg8::M_SCALE; E.o0 = (bf16_t*)(ws + WS_D1); E.gatev = mod + 2048; break;
        case 10: g.A = (const bf16_t*)(ws + WS_HB); g.Bt = (const bf16_t*)(ws + WS_WUP); g.N = FF2; g.K = 1024; g.permA = 1;
                E.mode = pg8::M_CONV; E.o0 = (bf16_t*)(ws + WS_ACT); E.o1 = (bf16_t*)(ws + WS_HALO); E.cw = P->in[30]; E.cb = P->in[31]; break;
        case 12: g.A = (const bf16_t*)(ws + WS_ACT); g.Bt = (const bf16_t*)(ws + WS_WDN); g.N = 1024; g.K = FF;
                E.mode = pg8::M_SCALE; E.o0 = (bf16_t*)(ws + WS_HB); E.gatev = mod + 5120; break;
        default: is_gemm = false; break;
        }
        if (is_gemm && (PHM & 4u)) {
            int bid = blockIdx.x; LAUNDER_S(bid);
            pg8::StaticOrder S; S.init(g.M, g.N, (int)gridDim.x, bid);
            pg8::gemm_phase(lds, g, S, E);
        } else if (ph == 0 && (PHM & 1u)) {
            phase0(P, lds);
            {
                unsigned* ctr = (unsigned*)(ws + WS_CTL); unsigned sp = 0u;
                while (xb_ld(ctr) < gridDim.x) { __builtin_amdgcn_s_sleep(2); if (++sp > (1u << 22)) break; }
                __builtin_amdgcn_fence(__ATOMIC_ACQUIRE, "agent");
                asm volatile("s_waitcnt vmcnt(0)" ::: "memory");
            }
            phase_norm<0>(P->in[0], nullptr, nullptr, P->in[4], mod, 0, 1024, (bf16_t*)(ws + WS_HB), nullptr);
        } else if (ph == 1 && (PHM & 2u)) {
        } else if (ph == 3 && (PHM & 8u)) {
            phase_lora_in(P);
        } else if (ph == 5 && (PHM & 32u)) {
            phase_rwkv(P, lds, !rep);
        } else if (ph == 9 && (PHM & 2u)) {
            phase_norm<2>(P->in[0], (const bf16_t*)(ws + WS_D1), nullptr, P->in[28], mod, 3072, 4096, (bf16_t*)(ws + WS_HB), nullptr);
        } else if (ph == 11 && (PHM & 2048u)) {
            phase_fixup(P);
        } else if (ph == 13 && (PHM & 2u)) {
            phase_norm<1>(P->in[0], (const bf16_t*)(ws + WS_D1), (const bf16_t*)(ws + WS_HB), P->in[33], nullptr, 0, 0, nullptr, P->out);
        }
    }
}

extern "C" void kernel_launch(void* const* d_in, const int* in_sizes, int n_in, void* d_out, int out_size, void* d_ws, size_t ws_size, hipStream_t stream) {
    static int grid = 0;
    if (grid == 0) {
        if (n_in != 34 || in_sizes[0] != T_ * D_ || out_size != T_ * D_ || ws_size < WS_END) {
            fprintf(stderr, "kernel_launch: unexpected shapes: n_in %d in0 %d out %d ws %zu (need %zu)\n", n_in, n_in > 0 ? in_sizes[0] : -1, out_size, ws_size, (size_t)WS_END);
            grid = -1; return; }
        int dev = 0, cus = 0, per_cu = 0;
        (void)hipGetDevice(&dev);
        (void)hipDeviceGetAttribute(&cus, hipDeviceAttributeMultiprocessorCount, dev);
        if (hipFuncSetAttribute((const void*)mk_fwd, hipFuncAttributeMaxDynamicSharedMemorySize, LDS_BYTES) != hipSuccess) fprintf(stderr, "kernel_launch: hipFuncSetAttribute failed\n");
        if (hipOccupancyMaxActiveBlocksPerMultiprocessor(&per_cu, (const void*)mk_fwd, 512, LDS_BYTES) != hipSuccess || per_cu < 1) { fprintf(stderr, "kernel_launch: occupancy query gave %d\n", per_cu); per_cu = 1; }
        (void)hipGetLastError();
        if (cus <= 0) cus = 256;
        grid = cus;
    }
    if (grid < 0) return;
    (void)hipMemsetAsync((char*)d_ws + WS_CTL, 0, XCD_BAR_WORDS * 4, stream);
    Params p{};
    for (int i = 0; i < 34; ++i) p.in[i] = (const float*)d_in[i];
    p.out = (float*)d_out; p.ws = (unsigned char*)d_ws; p.ph_lo = 0; p.ph_hi = NPH;
    void* args[] = {&p};
    hipError_t e = hipLaunchCooperativeKernel((const void*)mk_fwd, dim3(grid), dim3(512), args, LDS_BYTES, stream);
    if (e != hipSuccess) fprintf(stderr, "cooperative launch failed: %s (grid %d)\n", hipGetErrorString(e), grid);
}
```
